# Optimizing an MI355X kernel written in HIP

```python
import jax, jax.numpy as jnp
from jax import lax
import numpy as np

D_MODEL = 1024
BATCH = 2
SEQ = 8192
DEPTH = 2

GRID_W = 64
CTX_LEN = 256
N_MIXERS = 2
EPS = 1e-6
D_RNN = D_MODEL
RG_BLOCKS = 8
RG_BW = D_RNN // RG_BLOCKS
CONV_W = 4
LRU_C = 8.0
HEAD_DIM = 128
N_HEADS = D_MODEL // HEAD_DIM
N_KV = 2
GROUPS = N_HEADS // N_KV
Q_BLOCK = 128
ROPE_THETA = 10000.0
ROPE_AXIS_DIM = HEAD_DIM // 2
ROPE_NFREQ = ROPE_AXIS_DIM // 2
D_FF = 2816
N_EXPERTS = 8
TOP_K = 2
D_FF_EXPERT = 3584
MOE_BLOCK = 128
N_A = (DEPTH + 1) // 2
N_B = DEPTH // 2
N_DENSE = (DEPTH + 1) // 2
N_MOE = DEPTH // 2

kernel_name = "hybrid_rglru_gqa_moe_diffusion_block"


def rmsnorm(x, g):
    xf = x.astype(jnp.float32)
    y = xf * lax.rsqrt(jnp.mean(xf * xf, axis=-1, keepdims=True) + EPS)
    return (y * g).astype(x.dtype)


def modulate(h, shift, scale):
    return h * (1 + scale) + shift


def dwconv_centered(x, w, b):
    L = x.shape[1]
    left = CONV_W // 2
    right = CONV_W - 1 - left
    xp = jnp.pad(x, ((0, 0), (left, right), (0, 0)))
    y = b
    for k in range(CONV_W):
        y = y + xp[:, k:k + L] * w[k]
    return y


def block_diag(x, w):
    B, L, _ = x.shape
    xb = x.reshape(B, L, RG_BLOCKS, RG_BW)
    return jnp.einsum('blnc,ncd->blnd', xb, w).reshape(B, L, RG_BLOCKS * RG_BW)


def lru_coeffs(xc, w_a, b_a, w_i, b_i, lam):
    xf = xc.astype(jnp.float32)
    r = jax.nn.sigmoid(block_diag(xf, w_a) + b_a)
    i = jax.nn.sigmoid(block_diag(xf, w_i) + b_i)
    log_a = -LRU_C * r * jax.nn.softplus(-lam.astype(jnp.float32))
    a = jnp.exp(log_a)
    mult = jnp.sqrt(-jnp.expm1(2.0 * log_a))
    return a, mult * (i * xf)


def linear_scan(a, b, h0, reverse):
    def combine(e1, e2):
        a1, b1 = e1
        a2, b2 = e2
        return a1 * a2, a2 * b1 + b2
    A, Bc = lax.associative_scan(combine, (a, b), reverse=reverse, axis=1)
    return A * h0[:, None, :] + Bc


def rglru_mixer(h_lat, h_ctx, w_in, conv_w, conv_b, w_a, b_a, w_i, b_i, lam, w_out, need_ctx):
    xb_l, gb_l = jnp.split(h_lat @ w_in, 2, axis=-1)
    xb_c, gb_c = jnp.split(h_ctx @ w_in, 2, axis=-1)
    xc_l = dwconv_centered(xb_l, conv_w, conv_b)
    xc_c = dwconv_centered(xb_c, conv_w, conv_b)
    ys_l, ys_c = [], []
    for d, reverse in enumerate((False, True)):
        a_c, b_c = lru_coeffs(xc_c, w_a[d], b_a[d], w_i[d], b_i[d], lam[d])
        h_c = linear_scan(a_c, b_c, jnp.zeros_like(a_c[:, 0]), reverse)
        h0 = h_c[:, 0] if reverse else h_c[:, -1]
        a_l, b_l = lru_coeffs(xc_l, w_a[d], b_a[d], w_i[d], b_i[d], lam[d])
        ys_l.append(linear_scan(a_l, b_l, h0, reverse))
        ys_c.append(h_c)
    y_l = (ys_l[0] + ys_l[1]).astype(h_lat.dtype)
    out_lat = (y_l * jax.nn.gelu(gb_l)) @ w_out
    out_ctx = None
    if need_ctx:
        y_c = (ys_c[0] + ys_c[1]).astype(h_ctx.dtype)
        out_ctx = (y_c * jax.nn.gelu(gb_c)) @ w_out
    return out_lat, out_ctx


def axial_rope_angles(L):
    rows = L // GRID_W
    row = jnp.broadcast_to(jnp.arange(rows)[:, None], (rows, GRID_W)).reshape(L).astype(jnp.float32)
    col = jnp.broadcast_to(jnp.arange(GRID_W)[None, :], (rows, GRID_W)).reshape(L).astype(jnp.float32)
    freqs = ROPE_THETA ** (-jnp.arange(ROPE_NFREQ, dtype=jnp.float32) / ROPE_NFREQ)
    return row[:, None] * freqs, col[:, None] * freqs


def rotate(x, ang):
    cos = jnp.cos(ang)[None, :, None, :].astype(x.dtype)
    sin = jnp.sin(ang)[None, :, None, :].astype(x.dtype)
    x1, x2 = x[..., :ROPE_NFREQ], x[..., ROPE_NFREQ:]
    return jnp.concatenate([x1 * cos - x2 * sin, x2 * cos + x1 * sin], axis=-1)


def apply_axial_rope(x, ang_row, ang_col):
    return jnp.concatenate([rotate(x[..., :ROPE_AXIS_DIM], ang_row),
                            rotate(x[..., ROPE_AXIS_DIM:], ang_col)], axis=-1)


def gqa_attend(q, k, v):
    s = jnp.einsum('bqkgd,bskd->bkgqs', q, k).astype(jnp.float32) * (HEAD_DIM ** -0.5)
    p = jax.nn.softmax(s, axis=-1).astype(v.dtype)
    return jnp.einsum('bkgqs,bskd->bqkgd', p, v)


def attn_mixer(h_lat, h_ctx, w_qkv, q_g, k_g, w_o, need_ctx):
    B, L, _ = h_lat.shape
    C = h_ctx.shape[1]
    nq = N_HEADS * HEAD_DIM
    nkv = N_KV * HEAD_DIM
    q_l, k_l, v_l = jnp.split(h_lat @ w_qkv, [nq, nq + nkv], axis=-1)
    q_l = rmsnorm(q_l.reshape(B, L, N_HEADS, HEAD_DIM), q_g)
    k_l = rmsnorm(k_l.reshape(B, L, N_KV, HEAD_DIM), k_g)
    v_l = v_l.reshape(B, L, N_KV, HEAD_DIM)
    ang_row, ang_col = axial_rope_angles(L)
    q_l = apply_axial_rope(q_l, ang_row, ang_col)
    k_l = apply_axial_rope(k_l, ang_row, ang_col)
    if need_ctx:
        q_c, k_c, v_c = jnp.split(h_ctx @ w_qkv, [nq, nq + nkv], axis=-1)
    else:
        k_c, v_c = jnp.split(h_ctx @ w_qkv[:, nq:], [nkv], axis=-1)
    k_c = rmsnorm(k_c.reshape(B, C, N_KV, HEAD_DIM), k_g)
    v_c = v_c.reshape(B, C, N_KV, HEAD_DIM)
    k_all = jnp.concatenate([k_c, k_l], axis=1)
    v_all = jnp.concatenate([v_c, v_l], axis=1)
    nb = L // Q_BLOCK
    qb = q_l.reshape(B, nb, Q_BLOCK, N_KV, GROUPS, HEAD_DIM).transpose(1, 0, 2, 3, 4, 5)
    o = lax.map(lambda qblk: gqa_attend(qblk, k_all, v_all), qb)
    o = o.transpose(1, 0, 2, 3, 4, 5).reshape(B, L, nq)
    out_lat = o @ w_o
    out_ctx = None
    if need_ctx:
        q_c = rmsnorm(q_c.reshape(B, C, N_HEADS, HEAD_DIM), q_g).reshape(B, C, N_KV, GROUPS, HEAD_DIM)
        out_ctx = gqa_attend(q_c, k_c, v_c).reshape(B, C, nq) @ w_o
    return out_lat, out_ctx


def swiglu(h, w1, w3, w2):
    return (jax.nn.silu(h @ w1) * (h @ w3)) @ w2


def moe_ffn(h, router, w1, w3, w2):
    shp = h.shape
    xt = h.reshape(-1, shp[-1])
    T = xt.shape[0]
    logits = (xt @ router).astype(jnp.float32)
    top_logit, top_idx = lax.top_k(logits, TOP_K)
    gates = jax.nn.softmax(top_logit, axis=-1).astype(h.dtype)
    TK = T * TOP_K
    slot_e = top_idx.reshape(TK)
    slot_tok = jnp.arange(TK, dtype=jnp.int32) // TOP_K
    slot_w = gates.reshape(TK)
    order = jnp.argsort(slot_e)
    e_sorted = slot_e[order]
    counts = jnp.bincount(slot_e, length=N_EXPERTS)
    padded = ((counts + MOE_BLOCK - 1) // MOE_BLOCK) * MOE_BLOCK
    start = jnp.cumsum(counts) - counts
    pend = jnp.cumsum(padded)
    pstart = pend - padded
    dest = pstart[e_sorted] + (jnp.arange(TK) - start[e_sorted])
    n_blocks = -(-TK // MOE_BLOCK) + N_EXPERTS
    P = n_blocks * MOE_BLOCK
    buf_tok = jnp.zeros((P,), jnp.int32).at[dest].set(slot_tok[order])
    buf_w = jnp.zeros((P,), h.dtype).at[dest].set(slot_w[order])
    blk_e = jnp.minimum(jnp.searchsorted(pend, jnp.arange(n_blocks) * MOE_BLOCK, side='right'), N_EXPERTS - 1)

    def run(args):
        tok, w, e = args
        xb = xt[tok]
        hid = jax.nn.silu(xb @ w1[e]) * (xb @ w3[e])
        return (hid @ w2[e]) * w[:, None]

    y = lax.map(run, (buf_tok.reshape(n_blocks, MOE_BLOCK), buf_w.reshape(n_blocks, MOE_BLOCK), blk_e))
    out = jnp.zeros_like(xt).at[buf_tok].add(y.reshape(P, shp[-1]))
    return out.reshape(shp)


def setup_inputs(seed: int = 0) -> dict:
    key = jax.random.key(seed)
    ks = jax.random.split(key, 32)
    f32 = jnp.float32

    def nrm(k, shape, fan_in, mult=1.0):
        return jax.random.normal(k, shape, f32) * (mult * fan_in ** -0.5)

    def gain(k, shape):
        return 1.0 + 0.1 * jax.random.normal(k, shape, f32)

    def bias(k, shape):
        return 0.02 * jax.random.normal(k, shape, f32)

    u = jax.random.uniform(ks[16], (N_A, 2, D_RNN), f32, minval=0.9, maxval=0.999)
    s = u ** (1.0 / LRU_C)
    rg_lam = jnp.log(s) - jnp.log1p(-s)
    qkv_out = (N_HEADS + 2 * N_KV) * HEAD_DIM
    return {
        "x": jax.random.normal(ks[0], (BATCH, SEQ, D_MODEL), f32),
        "c": jax.random.normal(ks[1], (BATCH, D_MODEL), f32),
        "ctx": jax.random.normal(ks[2], (BATCH, CTX_LEN, D_MODEL), f32),
        "c_ctx": jax.random.normal(ks[3], (D_MODEL,), f32),
        "ada_w": nrm(ks[4], (DEPTH, D_MODEL, 6 * D_MODEL), D_MODEL, 0.5),
        "ada_b": bias(ks[5], (DEPTH, 6 * D_MODEL)),
        "norm1_g": gain(ks[6], (DEPTH, D_MODEL)),
        "norm2_g": gain(ks[7], (DEPTH, D_MODEL)),
        "rg_w_in": nrm(ks[8], (N_A, D_MODEL, 2 * D_RNN), D_MODEL),
        "rg_conv_w": nrm(ks[9], (N_A, CONV_W, D_RNN), CONV_W),
        "rg_conv_b": bias(ks[10], (N_A, D_RNN)),
        "rg_w_a": nrm(ks[11], (N_A, 2, RG_BLOCKS, RG_BW, RG_BW), RG_BW),
        "rg_b_a": bias(ks[12], (N_A, 2, D_RNN)),
        "rg_w_i": nrm(ks[13], (N_A, 2, RG_BLOCKS, RG_BW, RG_BW), RG_BW),
        "rg_b_i": bias(ks[14], (N_A, 2, D_RNN)),
        "rg_lam": rg_lam,
        "rg_w_out": nrm(ks[15], (N_A, D_RNN, D_MODEL), D_RNN),
        "attn_w_qkv": nrm(ks[17], (N_B, D_MODEL, qkv_out), D_MODEL),
        "attn_q_g": gain(ks[18], (N_B, HEAD_DIM)),
        "attn_k_g": gain(ks[19], (N_B, HEAD_DIM)),
        "attn_w_o": nrm(ks[20], (N_B, N_HEADS * HEAD_DIM, D_MODEL), N_HEADS * HEAD_DIM),
        "ffn_w1": nrm(ks[21], (N_DENSE, D_MODEL, D_FF), D_MODEL),
        "ffn_w3": nrm(ks[22], (N_DENSE, D_MODEL, D_FF), D_MODEL),
        "ffn_w2": nrm(ks[23], (N_DENSE, D_FF, D_MODEL), D_FF),
        "moe_router": nrm(ks[24], (N_MOE, D_MODEL, N_EXPERTS), D_MODEL),
        "moe_w1": nrm(ks[25], (N_MOE, N_EXPERTS, D_MODEL, D_FF_EXPERT), D_MODEL),
        "moe_w3": nrm(ks[26], (N_MOE, N_EXPERTS, D_MODEL, D_FF_EXPERT), D_MODEL),
        "moe_w2": nrm(ks[27], (N_MOE, N_EXPERTS, D_FF_EXPERT, D_MODEL), D_FF_EXPERT),
        "final_g": gain(ks[28], (D_MODEL,)),
    }


def reference(x, c, ctx, c_ctx, ada_w, ada_b, norm1_g, norm2_g,
              rg_w_in, rg_conv_w, rg_conv_b, rg_w_a, rg_b_a, rg_w_i, rg_b_i, rg_lam, rg_w_out,
              attn_w_qkv, attn_q_g, attn_k_g, attn_w_o,
              ffn_w1, ffn_w3, ffn_w2,
              moe_router, moe_w1, moe_w3, moe_w2, final_g):
    silu_c = jax.nn.silu(c)
    silu_cc = jax.nn.silu(c_ctx)
    for i in range(DEPTH):
        need_ctx = i < DEPTH - 1
        j = i // N_MIXERS
        mod_l = (silu_c @ ada_w[i] + ada_b[i])[:, None, :]
        sh1, sc1, g1, sh2, sc2, g2 = jnp.split(mod_l, 6, axis=-1)
        mod_c = silu_cc @ ada_w[i] + ada_b[i]
        csh1, csc1, cg1, csh2, csc2, cg2 = jnp.split(mod_c, 6, axis=-1)
        h_l = modulate(rmsnorm(x, norm1_g[i]), sh1, sc1)
        h_c = modulate(rmsnorm(ctx, norm1_g[i]), csh1, csc1)
        if i % N_MIXERS == 0:
            m_l, m_c = rglru_mixer(h_l, h_c, rg_w_in[j], rg_conv_w[j], rg_conv_b[j], rg_w_a[j], rg_b_a[j],
                                   rg_w_i[j], rg_b_i[j], rg_lam[j], rg_w_out[j], need_ctx)
        else:
            m_l, m_c = attn_mixer(h_l, h_c, attn_w_qkv[j], attn_q_g[j], attn_k_g[j], attn_w_o[j], need_ctx)
        x = x + g1 * m_l
        h_l = modulate(rmsnorm(x, norm2_g[i]), sh2, sc2)
        if i % 2 == 0:
            ffn = lambda h: swiglu(h, ffn_w1[j], ffn_w3[j], ffn_w2[j])
        else:
            ffn = lambda h: moe_ffn(h, moe_router[j], moe_w1[j], moe_w3[j], moe_w2[j])
        x = x + g2 * ffn(h_l)
        if need_ctx:
            ctx = ctx + cg1 * m_c
            h_c = modulate(rmsnorm(ctx, norm2_g[i]), csh2, csc2)
            ctx = ctx + cg2 * ffn(h_c)
    return rmsnorm(x, final_g)
```

```cpp
#include <hip/hip_runtime.h>
#include <hip/hip_bf16.h>
#include <cstdio>
#include <cstdint>

#ifndef MK_SINGLE
#define MK_SINGLE 1
#endif

#define GAS __attribute__((address_space(1)))
#define LAS __attribute__((address_space(3)))
typedef unsigned short bf16_t;
typedef short bf16x8 __attribute__((ext_vector_type(8)));
typedef float f32x4 __attribute__((ext_vector_type(4)));
typedef float f32x2 __attribute__((ext_vector_type(2)));
typedef float f32x16 __attribute__((ext_vector_type(16)));
typedef unsigned u32x4 __attribute__((ext_vector_type(4)));
typedef unsigned u32x2 __attribute__((ext_vector_type(2)));
typedef GAS unsigned gu32;

constexpr int D = 1024, NB = 2, SEQ = 8192, CL = 256;
constexpr int TL = NB * SEQ, TC = NB * CL, TA = TL + TC;
constexpr int DFF = 2816, NE = 8, DFE = 3584;
constexpr int NQKV = 1536, HD = 128, SKV = CL + SEQ;
constexpr float EPS = 1e-6f;
constexpr int NWAVES = 8, NTHR = 512;
constexpr int SCH = 32, NCHUNK = TA / SCH;
constexpr int MAXMT = 135;

constexpr size_t MiB = 1u << 20;
constexpr size_t WS_CTL = 0, CTL_ZERO_BYTES = 1 * MiB;
constexpr size_t WS_MOD = 1 * MiB;
constexpr size_t WS_C8 = WS_MOD + 160 * 1024;
constexpr size_t WS_TOKE = WS_MOD + 192 * 1024;
constexpr size_t WS_TOKW = WS_MOD + 256 * 1024;
constexpr size_t WS_RANK = WS_MOD + 384 * 1024;
constexpr size_t WS_DEST = WS_MOD + 512 * 1024;
constexpr size_t WS_TILEE = WS_MOD + 640 * 1024;
constexpr size_t WS_CTXR = 2 * MiB;
constexpr size_t WS_W_IN = 4 * MiB, WS_W_GATE = 8 * MiB, WS_W_OUT = 9 * MiB, WS_W_QKV = 11 * MiB, WS_W_O = 14 * MiB, WS_W13 = 16 * MiB, WS_W2 = 27 * MiB;
constexpr size_t WS_MW13 = 33 * MiB, WS_MW2 = 145 * MiB;
constexpr size_t WS_H = 201 * MiB;
constexpr size_t WS_XG = 234 * MiB;
constexpr size_t WS_XC = 300 * MiB, WS_YG = 300 * MiB;
constexpr size_t WS_LA = 333 * MiB, WS_BB = 399 * MiB;
constexpr size_t WS_AGGP = 465 * MiB, WS_AGGQ = 470 * MiB, WS_CARRY = 475 * MiB;
constexpr size_t WS_HID = 234 * MiB;
constexpr size_t WS_Q = 234 * MiB, WS_KB = 266 * MiB, WS_VB = 275 * MiB, WS_O = 284 * MiB;
constexpr size_t WS_H2 = 320 * MiB;
constexpr size_t WS_XGATH = 201 * MiB, WS_Y = 201 * MiB;
constexpr size_t WS_MHID = 269 * MiB;
constexpr size_t WS_END = WS_MHID + (size_t)MAXMT * 256 * DFE * 2;
static_assert(WS_END <= 531788800ull, "workspace map exceeds sum(inputs)");
constexpr int CW_GCNT = 64;
constexpr int CW_BAR = 4096;

constexpr int RING_BYTES = 131072;
constexpr int LDSCTL_OFF = RING_BYTES, MISC_OFF = LDSCTL_OFF + 320;
constexpr int LDS_BYTES = 147456;

#define RLX_AGENT __ATOMIC_RELAXED, __HIP_MEMORY_SCOPE_AGENT
__device__ __forceinline__ unsigned f2bf(float f) { unsigned u = __builtin_bit_cast(unsigned, f); return (u + 0x7fffu + ((u >> 16) & 1u)) >> 16; }
__device__ __forceinline__ unsigned pk2(float lo, float hi) { return f2bf(lo) | (f2bf(hi) << 16); }
__device__ __forceinline__ float bf2f(unsigned short b) { return __builtin_bit_cast(float, (unsigned)b << 16); }
__device__ __forceinline__ float bflo(unsigned w) { return __builtin_bit_cast(float, w << 16); }
__device__ __forceinline__ float bfhi(unsigned w) { return __builtin_bit_cast(float, w & 0xffff0000u); }
__device__ __forceinline__ float wave_sum(float v) {
#pragma unroll
    for (int o = 1; o < 64; o <<= 1) v += __shfl_xor(v, o);
    return v;
}
__device__ __forceinline__ float sigmoidf_(float x) { return 1.0f / (1.0f + __expf(-x)); }
__device__ __forceinline__ float siluf_(float x) { return x / (1.0f + __expf(-x)); }
__device__ __forceinline__ float gelu_tanh(float x) { const float u = 0.7978845608028654f * (x + 0.044715f * x * x * x); return 0.5f * x * (1.0f + tanhf(u)); }

#define XB_TMO      128
#define XB_XCNT(j)  (256  + 64 * (j))
#define XB_XSUB(j)  (1280 + 64 * (j))
#define XB_XGEN(j)  (2304 + 64 * (j))
#define XB_TOP      3328
#define XB_TOPGEN   3392
#define XCD_BAR_WORDS 3456
#define XB_SPIN_CAP (1u << 18)
__device__ __forceinline__ unsigned xb_ld(unsigned* p)              { return __hip_atomic_load(p, __ATOMIC_RELAXED, __HIP_MEMORY_SCOPE_AGENT); }
__device__ __forceinline__ unsigned xb_add(unsigned* p, unsigned v) { return __hip_atomic_fetch_add(p, v, __ATOMIC_RELAXED, __HIP_MEMORY_SCOPE_AGENT); }
__device__ __forceinline__ unsigned xb_xcc_id() { return (unsigned)__builtin_amdgcn_s_getreg((3 << 11) | 20) & 0xFu; }
#define XB_SPIN(cond, bar) do { unsigned _sp = 0; while (cond) { __builtin_amdgcn_s_sleep(1); \
    if ((++_sp & 255u) == 0u) { if (xb_ld(&(bar)[XB_TMO])) break; if (_sp > XB_SPIN_CAP) { atomicAdd(&(bar)[XB_TMO], 1u); break; } } } } while (0)
struct XcdBarrier { unsigned* bar; unsigned x; volatile LAS unsigned* st; };
__device__ __forceinline__ XcdBarrier xcd_barrier_post(unsigned* bar, volatile LAS unsigned* st) {
    XcdBarrier b; b.bar = bar; b.x = xb_xcc_id(); b.st = st;
    if (threadIdx.x == 0) (void)xb_add(&bar[XB_XCNT(b.x)], 1u);
    return b;
}
__device__ __forceinline__ void xcd_barrier_complete(unsigned* bar, unsigned x, unsigned& nloc, unsigned& nx) {
    const unsigned G = gridDim.x * gridDim.y * gridDim.z;
    unsigned sum, cnt, mine, sp = 0u;
    for (;;) {
        sum = 0u; cnt = 0u; mine = 0u;
#pragma unroll
        for (unsigned j = 0; j < 16; ++j) { const unsigned c = xb_ld(&bar[XB_XCNT(j)]); sum += c; cnt += (c > 0u) ? 1u : 0u; mine = (j == x) ? c : mine; }
        if (sum == G) break;
        __builtin_amdgcn_s_sleep(1);
        if ((++sp & 255u) == 0u) { if (xb_ld(&bar[XB_TMO])) break; if (sp > XB_SPIN_CAP) { atomicAdd(&bar[XB_TMO], 1u); break; } }
    }
    nloc = mine > 0u ? mine : 1u; nx = cnt > 0u ? cnt : 1u;
}
__device__ __forceinline__ void xcd_barrier(const XcdBarrier& b) {
    asm volatile("s_waitcnt vmcnt(0)" ::: "memory");
    __syncthreads();
    if (threadIdx.x == 0) {
        unsigned* bar = b.bar;
        __builtin_amdgcn_s_waitcnt(0);
        unsigned nloc = b.st[0], nx = b.st[1];
        if (nloc == 0u) { xcd_barrier_complete(bar, b.x, nloc, nx); b.st[0] = nloc; b.st[1] = nx; }
        const unsigned old = xb_add(&bar[XB_XSUB(b.x)], 1u);
        const unsigned gen = old / nloc;
        if (old + 1u == (gen + 1u) * nloc) {
            __builtin_amdgcn_fence(__ATOMIC_RELEASE, "agent");
            asm volatile("s_waitcnt vmcnt(0)" ::: "memory");
            const unsigned og = xb_add(&bar[XB_TOP], 1u);
            const unsigned tg = og / nx;
            if (og + 1u == (tg + 1u) * nx) xb_add(&bar[XB_TOPGEN], 1u);
            else XB_SPIN(xb_ld(&bar[XB_TOPGEN]) == tg, bar);
            __builtin_amdgcn_fence(__ATOMIC_ACQUIRE, "agent");
            xb_add(&bar[XB_XGEN(b.x)], 1u);
            asm volatile("s_waitcnt vmcnt(0)" ::: "memory");
        } else {
            XB_SPIN(xb_ld(&bar[XB_XGEN(b.x)]) == gen, bar);
            __builtin_amdgcn_fence(__ATOMIC_ACQUIRE, "agent");
            asm volatile("s_waitcnt vmcnt(0)" ::: "memory");
        }
    }
    __syncthreads();
}

struct Frame {
    unsigned char* lds; int tid, lane, wave, vcu, G;
    const float* in[29]; float* out; unsigned char* ws;
};
struct Unit { int pm, pn; };
__device__ __forceinline__ int tile_which(int pm) { return pm < 64 ? (pm >> 5) : 2; }

constexpr int SG_LDT = 72;
template <class Epi>
__device__ __forceinline__ void sgemm_unit(unsigned char* lds, const bf16_t* A, int lda, const bf16_t* Bt, int ldb, int K, const Epi& E, const Unit u) {
    const int tid = threadIdx.x, wid = tid >> 6, lane = tid & 63, wr = wid >> 2, wc = wid & 3, fr = lane & 15, fq = lane >> 4;
    f32x4 acc[2][2][4][2];
#pragma unroll
    for (int a = 0; a < 2; ++a)
#pragma unroll
        for (int b = 0; b < 2; ++b)
#pragma unroll
            for (int m = 0; m < 4; ++m)
#pragma unroll
                for (int n = 0; n < 2; ++n) acc[a][b][m][n] = (f32x4){0.f, 0.f, 0.f, 0.f};
    bf16_t* As = (bf16_t*)lds; bf16_t* Bs = As + 256 * SG_LDT;
    for (int k0 = 0; k0 < K; k0 += 64) {
        bf16x8 ra[4], rb[4];
#pragma unroll
        for (int i = 0; i < 4; ++i) { const int p = tid + 512 * i, row = p >> 3, kc = (p & 7) * 8;
            ra[i] = *(const bf16x8*)(A + (size_t)row * lda + k0 + kc); rb[i] = *(const bf16x8*)(Bt + (size_t)row * ldb + k0 + kc); }
        __syncthreads();
#pragma unroll
        for (int i = 0; i < 4; ++i) { const int p = tid + 512 * i, row = p >> 3, kc = (p & 7) * 8;
            *(bf16x8*)(As + row * SG_LDT + kc) = ra[i]; *(bf16x8*)(Bs + row * SG_LDT + kc) = rb[i]; }
        __syncthreads();
#pragma unroll
        for (int kk = 0; kk < 2; ++kk) {
            bf16x8 bfr[2][2];
#pragma unroll
            for (int bj = 0; bj < 2; ++bj)
#pragma unroll
                for (int n = 0; n < 2; ++n) bfr[bj][n] = *(const bf16x8*)(Bs + (128 * bj + 32 * wc + 16 * n + fr) * SG_LDT + 32 * kk + 8 * fq);
#pragma unroll
            for (int ai = 0; ai < 2; ++ai) {
                bf16x8 af[4];
#pragma unroll
                for (int m = 0; m < 4; ++m) af[m] = *(const bf16x8*)(As + (128 * ai + 64 * wr + 16 * m + fr) * SG_LDT + 32 * kk + 8 * fq);
#pragma unroll
                for (int bj = 0; bj < 2; ++bj)
#pragma unroll
                    for (int m = 0; m < 4; ++m)
#pragma unroll
                        for (int n = 0; n < 2; ++n) acc[ai][bj][m][n] = __builtin_amdgcn_mfma_f32_16x16x32_bf16(bfr[bj][n], af[m], acc[ai][bj][m][n], 0, 0, 0);
            }
        }
    }
    __syncthreads();
    E(acc, u, wr, wc, fr, fq);
}

template <bool PERM> __device__ __forceinline__ int epi_col(int bj, int n, int wc, int fq) { return PERM ? (128 * bj + 32 * wc + 8 * fq + 4 * n) : (128 * bj + 32 * wc + 16 * n + 4 * fq); }
#define EPI_LOOP4 _Pragma("unroll") for (int ai = 0; ai < 2; ++ai) _Pragma("unroll") for (int m = 0; m < 4; ++m) _Pragma("unroll") for (int bj = 0; bj < 2; ++bj) _Pragma("unroll") for (int n = 0; n < 2; ++n)
__device__ __forceinline__ void st_bf16x4(bf16_t* p, f32x4 v) { u32x2 w; w.x = pk2(v[0], v[1]); w.y = pk2(v[2], v[3]); *(u32x2*)p = w; }

struct EpiStoreBf16 {
    static constexpr bool PERM = false;
    bf16_t* O; int ldc;
    __device__ __forceinline__ void operator()(const f32x4 (&acc)[2][2][4][2], const Unit& u, int wr, int wc, int fr, int fq) const {
        EPI_LOOP4 { const int row = u.pm * 256 + 128 * ai + 64 * wr + 16 * m + fr, col = u.pn * 256 + epi_col<PERM>(bj, n, wc, fq);
            st_bf16x4(O + (size_t)row * ldc + col, acc[ai][bj][m][n]); }
    }
};
struct EpiQKV {
    static constexpr bool PERM = false;
    bf16_t *Q, *KB, *VB;
    __device__ __forceinline__ void operator()(const f32x4 (&acc)[2][2][4][2], const Unit& u, int wr, int wc, int fr, int fq) const {
        if (u.pn < 4 && u.pm >= 64) return;
        EPI_LOOP4 { const int row = u.pm * 256 + 128 * ai + 64 * wr + 16 * m + fr, c = epi_col<PERM>(bj, n, wc, fq);
            if (u.pn < 4) st_bf16x4(Q + (size_t)row * 1024 + u.pn * 256 + c, acc[ai][bj][m][n]);
            else { int kvrow; if (row < TL) { const int b = row >> 13, t = row & 8191; kvrow = b * SKV + CL + t; } else { const int r2 = row - TL, b = r2 >> 8, t = r2 & 255; kvrow = b * SKV + t; }
                bf16_t* base = (u.pn == 4) ? KB : VB; st_bf16x4(base + (size_t)kvrow * 256 + c, acc[ai][bj][m][n]); } }
    }
};
struct EpiResid {
    static constexpr bool PERM = false;
    const float* base_lat; float* out_lat; const float* base_ctx; float* out_ctx; const float* modl; int goff;
    __device__ __forceinline__ void operator()(const f32x4 (&acc)[2][2][4][2], const Unit& u, int wr, int wc, int fr, int fq) const {
        const float* g = modl + tile_which(u.pm) * 6144 + goff;
        const bool lat = u.pm < 64; const float* base = lat ? base_lat : base_ctx; float* out = lat ? out_lat : out_ctx; const int r0 = lat ? u.pm * 256 : (u.pm - 64) * 256;
        EPI_LOOP4 { const int row = r0 + 128 * ai + 64 * wr + 16 * m + fr, col = u.pn * 256 + epi_col<PERM>(bj, n, wc, fq);
            const f32x4 gv = *(const f32x4*)(g + col), bv = *(const f32x4*)(base + (size_t)row * 1024 + col);
            *(f32x4*)(out + (size_t)row * 1024 + col) = bv + gv * acc[ai][bj][m][n]; }
    }
};
struct EpiSwiglu {
    static constexpr bool PERM = false;
    bf16_t* O; int ldc;
    __device__ __forceinline__ void operator()(const f32x4 (&acc)[2][2][4][2], const Unit& u, int wr, int wc, int fr, int fq) const {
#pragma unroll
        for (int ai = 0; ai < 2; ++ai)
#pragma unroll
            for (int m = 0; m < 4; ++m)
#pragma unroll
                for (int n = 0; n < 2; ++n) { const int row = u.pm * 256 + 128 * ai + 64 * wr + 16 * m + fr, col = u.pn * 128 + epi_col<PERM>(0, n, wc, fq);
                    const f32x4 a = acc[ai][0][m][n], b = acc[ai][1][m][n]; f32x4 h;
#pragma unroll
                    for (int j = 0; j < 4; ++j) h[j] = siluf_(a[j]) * b[j];
                    st_bf16x4(O + (size_t)row * ldc + col, h); }
    }
};
struct EpiGates {
    static constexpr bool PERM = false;
    const bf16_t* XC; bf16_t *LA, *BB; const float *b_a, *b_i, *c8; int blk;
    __device__ __forceinline__ void operator()(const f32x4 (&acc)[2][2][4][2], const Unit& u, int wr, int wc, int fr, int fq) const {
        const int d = u.pn;
#pragma unroll
        for (int n = 0; n < 2; ++n) { const int ch = blk * 128 + epi_col<PERM>(0, n, wc, fq);
            const f32x4 ba = *(const f32x4*)(b_a + d * 1024 + ch), bi = *(const f32x4*)(b_i + d * 1024 + ch), cc = *(const f32x4*)(c8 + d * 1024 + ch);
#pragma unroll
            for (int ai = 0; ai < 2; ++ai)
#pragma unroll
                for (int m = 0; m < 4; ++m) { const int row = u.pm * 256 + 128 * ai + 64 * wr + 16 * m + fr;
                    const u32x2 xw = *(const u32x2*)(XC + (size_t)row * 1024 + ch); const float xc[4] = {bflo(xw.x), bfhi(xw.x), bflo(xw.y), bfhi(xw.y)};
                    f32x4 la, bb;
#pragma unroll
                    for (int j = 0; j < 4; ++j) { const float r = sigmoidf_(acc[ai][0][m][n][j] + ba[j]), ig = sigmoidf_(acc[ai][1][m][n][j] + bi[j]);
                        const float l = cc[j] * r; la[j] = l; bb[j] = sqrtf(-expm1f(2.0f * l)) * (ig * xc[j]); }
                    const size_t o = ((size_t)d * TA + row) * 1024 + ch; st_bf16x4(LA + o, la); st_bf16x4(BB + o, bb); } }
    }
};

__device__ __forceinline__ void p0_item(const float* W, int ldw, int k0, int n0, bf16_t* dst_row0, int ldd, LAS float* scr, int lane) {
#pragma unroll 8
    for (int i = 0; i < 32; ++i) { const int kk = 2 * i + (lane >> 5); scr[kk * 33 + (lane & 31)] = W[(size_t)(k0 + kk) * ldw + n0 + (lane & 31)]; }
    asm volatile("s_waitcnt lgkmcnt(0)" ::: "memory");
    const int c = lane & 7;
#pragma unroll
    for (int j = 0; j < 4; ++j) { const int n = (lane >> 3) + 8 * j; const LAS float* s = scr + (8 * c) * 33 + n;
        u32x4 o; o.x = pk2(s[0 * 33], s[1 * 33]); o.y = pk2(s[2 * 33], s[3 * 33]); o.z = pk2(s[4 * 33], s[5 * 33]); o.w = pk2(s[6 * 33], s[7 * 33]);
        *(u32x4*)(dst_row0 + (size_t)n * ldd + k0 + 8 * c) = o; }
    asm volatile("s_waitcnt lgkmcnt(0)" ::: "memory");
}
__device__ __forceinline__ int il_row(int n, int up) { return (n >> 7) * 256 + up * 128 + (n & 127); }

__device__ __forceinline__ void p0_prologue(Frame& F) {
    unsigned char* ws = F.ws;
    if (F.vcu < 192) {
        float* sv = (float*)F.lds;
        float* red = sv + 3 * 1024;
        for (int i = F.tid; i < 3 * 1024; i += NTHR) { const int w = i >> 10, k = i & 1023; const float v = (w < 2) ? F.in[1][w * 1024 + k] : F.in[3][k]; sv[i] = siluf_(v); }
        __syncthreads();
        const int layer = F.vcu / 96, n0 = (F.vcu % 96) * 64;
        const float* W = F.in[4] + (size_t)layer * 1024 * 6144 + n0 + F.lane;
        float a0 = 0.f, a1 = 0.f, a2 = 0.f;
#pragma unroll 8
        for (int k = F.wave * 128; k < F.wave * 128 + 128; ++k) { const float w = W[(size_t)k * 6144]; a0 += sv[k] * w; a1 += sv[1024 + k] * w; a2 += sv[2048 + k] * w; }
        red[(F.wave * 3 + 0) * 64 + F.lane] = a0; red[(F.wave * 3 + 1) * 64 + F.lane] = a1; red[(F.wave * 3 + 2) * 64 + F.lane] = a2;
        __syncthreads();
        if (F.tid < 192) { const int w = F.tid >> 6, l = F.tid & 63; float s = 0.f;
#pragma unroll
            for (int q = 0; q < 8; ++q) s += red[(q * 3 + w) * 64 + l];
            ((float*)(ws + WS_MOD))[(size_t)(layer * 3 + w) * 6144 + n0 + l] = s + F.in[5][layer * 6144 + n0 + l]; }
        __syncthreads();
    }
    if (F.vcu == 255) for (int i = F.tid; i < 2048; i += NTHR) { const float lam = F.in[15][i]; const float sp = (-lam > 20.f) ? -lam : log1pf(__expf(-lam)); ((float*)(ws + WS_C8))[i] = -8.0f * sp; }
    LAS float* scr = (LAS float*)(F.lds) + F.wave * 4096;
    const int gw = F.vcu * NWAVES + F.wave, NGW = F.G * NWAVES;
    constexpr int I_IN = 16 * 64, I_G = 32 * 8, I_OUT = 16 * 32, I_QKV = 16 * 48, I_O = 16 * 32, I_F1 = 16 * 88, I_F2 = 44 * 32, I_M1 = 16 * 112, I_M2 = 56 * 32;
    constexpr int NITEMS = I_IN + I_G + I_OUT + I_QKV + I_O + 2 * I_F1 + I_F2 + 16 * I_M1 + 8 * I_M2;
    for (int it = gw; it < NITEMS; it += NGW) {
        int r = it;
        if (r < I_IN) { const int kb = r / 64, nb = r % 64; p0_item(F.in[8], 2048, kb * 64, nb * 32, (bf16_t*)(ws + WS_W_IN) + (size_t)(nb * 32) * 1024, 1024, scr, F.lane); continue; } r -= I_IN;
        if (r < I_G) { const int mat = r >> 3, kb = (r >> 2) & 1, nb = r & 3; const int d = mat >> 4, gate = (mat >> 3) & 1, blk = mat & 7;
            const float* src = (gate ? F.in[13] : F.in[11]) + (size_t)(d * 8 + blk) * 128 * 128;
            p0_item(src, 128, kb * 64, nb * 32, (bf16_t*)(ws + WS_W_GATE) + (size_t)(blk * 512 + (d * 2 + gate) * 128 + nb * 32) * 128, 128, scr, F.lane); continue; } r -= I_G;
        if (r < I_OUT) { const int kb = r / 32, nb = r % 32; p0_item(F.in[16], 1024, kb * 64, nb * 32, (bf16_t*)(ws + WS_W_OUT) + (size_t)(nb * 32) * 1024, 1024, scr, F.lane); continue; } r -= I_OUT;
        if (r < I_QKV) { const int kb = r / 48, nb = r % 48; p0_item(F.in[17], 1536, kb * 64, nb * 32, (bf16_t*)(ws + WS_W_QKV) + (size_t)(nb * 32) * 1024, 1024, scr, F.lane); continue; } r -= I_QKV;
        if (r < I_O) { const int kb = r / 32, nb = r % 32; p0_item(F.in[20], 1024, kb * 64, nb * 32, (bf16_t*)(ws + WS_W_O) + (size_t)(nb * 32) * 1024, 1024, scr, F.lane); continue; } r -= I_O;
        if (r < 2 * I_F1) { const int up = r / I_F1, q = r % I_F1, kb = q / 88, nb = q % 88;
            p0_item(up ? F.in[22] : F.in[21], DFF, kb * 64, nb * 32, (bf16_t*)(ws + WS_W13) + (size_t)il_row(nb * 32, up) * 1024, 1024, scr, F.lane); continue; } r -= 2 * I_F1;
        if (r < I_F2) { const int kb = r / 32, nb = r % 32; p0_item(F.in[23], 1024, kb * 64, nb * 32, (bf16_t*)(ws + WS_W2) + (size_t)(nb * 32) * DFF, DFF, scr, F.lane); continue; } r -= I_F2;
        if (r < 16 * I_M1) { const int up = r / (8 * I_M1), q = r % (8 * I_M1), e = q / I_M1, q2 = q % I_M1, kb = q2 / 112, nb = q2 % 112;
            p0_item((up ? F.in[26] : F.in[25]) + (size_t)e * 1024 * DFE, DFE, kb * 64, nb * 32, (bf16_t*)(ws + WS_MW13) + ((size_t)e * 2 * DFE + il_row(nb * 32, up)) * 1024, 1024, scr, F.lane); continue; } r -= 16 * I_M1;
        { const int e = r / I_M2, q2 = r % I_M2, kb = q2 / 32, nb = q2 % 32;
            p0_item(F.in[27] + (size_t)e * DFE * 1024, 1024, kb * 64, nb * 32, (bf16_t*)(ws + WS_MW2) + ((size_t)e * 1024 + nb * 32) * DFE, DFE, scr, F.lane); }
    }
}

template <bool ROUTER>
__device__ __forceinline__ void modnorm_phase(Frame& F, const float* src_lat, const float* src_ctx, int nrows, const float* normg, const float* modl, int sh_idx, int sc_idx, bf16_t* H) {
    LAS float* RT = (LAS float*)F.lds;
    LAS int* lcnt = (LAS int*)(F.lds + 32768);
    LAS int* lrow = (LAS int*)(F.lds + 32768 + 64);
    if (ROUTER) {
        for (int i = F.tid; i < 8192; i += NTHR) RT[i] = F.in[24][i];
        if (F.tid < 16) lcnt[F.tid] = 0;
        __syncthreads();
    }
    int nloc = 0;
    for (int row = F.vcu * NWAVES + F.wave; row < nrows; row += F.G * NWAVES, ++nloc) {
        const bool lat = row < TL; const float* xr = lat ? src_lat + (size_t)row * 1024 : src_ctx + (size_t)(row - TL) * 1024;
        const int which = lat ? (row >> 13) : 2; const float* sh = modl + which * 6144 + sh_idx * 1024; const float* sc = modl + which * 6144 + sc_idx * 1024;
        f32x4 v[4]; float ss = 0.f;
#pragma unroll
        for (int j = 0; j < 4; ++j) { v[j] = *(const f32x4*)(xr + 4 * F.lane + 256 * j); ss += (v[j][0] * v[j][0] + v[j][1] * v[j][1]) + (v[j][2] * v[j][2] + v[j][3] * v[j][3]); }
        const float rstd = 1.0f / sqrtf(wave_sum(ss) * (1.0f / 1024.0f) + EPS);
#pragma unroll
        for (int j = 0; j < 4; ++j) { const int c = 4 * F.lane + 256 * j; const f32x4 g = *(const f32x4*)(normg + c), s1 = *(const f32x4*)(sc + c), s0 = *(const f32x4*)(sh + c);
            v[j] = (v[j] * rstd * g) * (1.0f + s1) + s0;
            st_bf16x4(H + (size_t)row * 1024 + c, v[j]); }
        if (ROUTER) {
            float lg[8];
#pragma unroll
            for (int e = 0; e < 8; ++e) lg[e] = 0.f;
#pragma unroll
            for (int j = 0; j < 4; ++j)
#pragma unroll
                for (int i = 0; i < 4; ++i) { const int k = 4 * F.lane + 256 * j + i; const f32x4 r0 = *(const LAS f32x4*)(RT + k * 8), r1 = *(const LAS f32x4*)(RT + k * 8 + 4); const float h = v[j][i];
                    lg[0] += h * r0[0]; lg[1] += h * r0[1]; lg[2] += h * r0[2]; lg[3] += h * r0[3]; lg[4] += h * r1[0]; lg[5] += h * r1[1]; lg[6] += h * r1[2]; lg[7] += h * r1[3]; }
#pragma unroll
            for (int e = 0; e < 8; ++e) lg[e] = wave_sum(lg[e]);
            int e0 = 0; float l0 = lg[0];
#pragma unroll
            for (int e = 1; e < 8; ++e) if (lg[e] > l0) { l0 = lg[e]; e0 = e; }
            int e1 = -1; float l1 = -3.0e38f;
#pragma unroll
            for (int e = 0; e < 8; ++e) if (e != e0 && lg[e] > l1) { l1 = lg[e]; e1 = e; }
            const float p1 = __expf(l1 - l0), w0 = 1.0f / (1.0f + p1), w1 = p1 / (1.0f + p1);
            if (F.lane == 0) {
                ((float*)(F.ws + WS_TOKW))[row * 2 + 0] = w0; ((float*)(F.ws + WS_TOKW))[row * 2 + 1] = w1;
                const int r0 = atomicAdd((int*)&((int*)lcnt)[e0], 1), r1 = atomicAdd((int*)&((int*)lcnt)[e1], 1);
                const int li = nloc * NWAVES + F.wave; lrow[li * 5 + 0] = row; lrow[li * 5 + 1] = e0; lrow[li * 5 + 2] = e1; lrow[li * 5 + 3] = r0; lrow[li * 5 + 4] = r1;
            }
        }
    }
    if (ROUTER) {
        __syncthreads();
        if (F.tid < 8) lcnt[8 + F.tid] = (int)__hip_atomic_fetch_add((unsigned*)(F.ws + WS_CTL) + CW_GCNT + F.tid, (unsigned)lcnt[F.tid], RLX_AGENT);
        __syncthreads();
        for (int li = F.tid; li < 128; li += NTHR) { const int i = li / NWAVES, w = li % NWAVES; const int row = F.vcu * NWAVES + w + i * F.G * NWAVES;
            if (row < nrows) { const int e0 = lrow[li * 5 + 1], e1 = lrow[li * 5 + 2];
                ((int*)(F.ws + WS_TOKE))[row] = e0 | (e1 << 8);
                ((int*)(F.ws + WS_RANK))[row * 2 + 0] = lcnt[8 + e0] + lrow[li * 5 + 3]; ((int*)(F.ws + WS_RANK))[row * 2 + 1] = lcnt[8 + e1] + lrow[li * 5 + 4]; } }
        __syncthreads();
    }
}

__device__ __forceinline__ void conv_phase(Frame& F) {
    const bf16_t* XG = (const bf16_t*)(F.ws + WS_XG); bf16_t* XC = (bf16_t*)(F.ws + WS_XC);
    const float* cw = F.in[9]; const float* cb = F.in[10];
    const int total = TA * 128;
    for (int it = F.vcu * NTHR + F.tid; it < total; it += F.G * NTHR) {
        const int row = it >> 7, c0 = (it & 127) * 8;
        int t, len; if (row < TL) { t = row & 8191; len = SEQ; } else { t = (row - TL) & 255; len = CL; }
        float a[8];
#pragma unroll
        for (int j = 0; j < 8; ++j) a[j] = cb[c0 + j];
#pragma unroll
        for (int k = 0; k < 4; ++k) { const int tt = t + k - 2;
            if (tt >= 0 && tt < len) { const u32x4 xw = *(const u32x4*)(XG + (size_t)(row + k - 2) * 2048 + c0); const f32x4 w0 = *(const f32x4*)(cw + k * 1024 + c0), w1 = *(const f32x4*)(cw + k * 1024 + c0 + 4);
                a[0] += bflo(xw.x) * w0[0]; a[1] += bfhi(xw.x) * w0[1]; a[2] += bflo(xw.y) * w0[2]; a[3] += bfhi(xw.y) * w0[3];
                a[4] += bflo(xw.z) * w1[0]; a[5] += bfhi(xw.z) * w1[1]; a[6] += bflo(xw.w) * w1[2]; a[7] += bfhi(xw.w) * w1[3]; } }
        u32x4 o; o.x = pk2(a[0], a[1]); o.y = pk2(a[2], a[3]); o.z = pk2(a[4], a[5]); o.w = pk2(a[6], a[7]);
        *(u32x4*)(XC + (size_t)row * 1024 + c0) = o;
    }
}
__device__ __forceinline__ void scan_agg_phase(Frame& F) {
    const bf16_t* LA = (const bf16_t*)(F.ws + WS_LA); const bf16_t* BB = (const bf16_t*)(F.ws + WS_BB);
    float* AP = (float*)(F.ws + WS_AGGP); float* AQ = (float*)(F.ws + WS_AGGQ);
    const int total = 2 * NCHUNK * 512;
    for (int it = F.vcu * NTHR + F.tid; it < total; it += F.G * NTHR) {
        const int cp = it & 511, ck = (it >> 9) % NCHUNK, d = it / (512 * NCHUNK);
        const size_t base = ((size_t)d * TA + (size_t)ck * SCH) * 1024 + cp * 2;
        float p0 = 1.f, p1 = 1.f, q0 = 0.f, q1 = 0.f;
#pragma unroll 8
        for (int s = 0; s < SCH; ++s) { const int t = d ? (SCH - 1 - s) : s; const unsigned lw = *(const unsigned*)(LA + base + (size_t)t * 1024), bw = *(const unsigned*)(BB + base + (size_t)t * 1024);
            const float a0 = __expf(bflo(lw)), a1 = __expf(bfhi(lw)); p0 *= a0; p1 *= a1; q0 = a0 * q0 + bflo(bw); q1 = a1 * q1 + bfhi(bw); }
        const size_t o = ((size_t)d * NCHUNK + ck) * 1024 + cp * 2;
        *(f32x2*)(AP + o) = (f32x2){p0, p1}; *(f32x2*)(AQ + o) = (f32x2){q0, q1};
    }
}
__device__ __forceinline__ void scan_carry_phase(Frame& F) {
    const float* AP = (const float*)(F.ws + WS_AGGP); const float* AQ = (const float*)(F.ws + WS_AGGQ); float* CR = (float*)(F.ws + WS_CARRY);
    const int it = F.vcu * NTHR + F.tid;
    if (it < 2 * NB * 1024) {
        const int ch = it & 1023, b = (it >> 10) & 1, d = it >> 11;
        float h = 0.f;
        const int cbase = TL / SCH + b * (CL / SCH), lbase = b * (SEQ / SCH);
#pragma unroll 8
        for (int j = 0; j < CL / SCH; ++j) { const int ck = cbase + (d ? (CL / SCH - 1 - j) : j); const size_t o = ((size_t)d * NCHUNK + ck) * 1024 + ch; CR[o] = h; h = AP[o] * h + AQ[o]; }
#pragma unroll 8
        for (int j = 0; j < SEQ / SCH; ++j) { const int ck = lbase + (d ? (SEQ / SCH - 1 - j) : j); const size_t o = ((size_t)d * NCHUNK + ck) * 1024 + ch; CR[o] = h; h = AP[o] * h + AQ[o]; }
    }
}
__device__ __forceinline__ void scan_apply_phase(Frame& F) {
    const bf16_t* LA = (const bf16_t*)(F.ws + WS_LA); const bf16_t* BB = (const bf16_t*)(F.ws + WS_BB); const float* CR = (const float*)(F.ws + WS_CARRY);
    const bf16_t* XG = (const bf16_t*)(F.ws + WS_XG); bf16_t* YG = (bf16_t*)(F.ws + WS_YG);
    const int total = NCHUNK * 512;
    for (int it = F.vcu * NTHR + F.tid; it < total; it += F.G * NTHR) {
        const int cp = it & 511, ck = it >> 9;
        float y0[SCH], y1[SCH];
        { const size_t base = ((size_t)ck * SCH) * 1024 + cp * 2; const f32x2 c = *(const f32x2*)(CR + (size_t)ck * 1024 + cp * 2); float h0 = c.x, h1 = c.y;
#pragma unroll
            for (int t = 0; t < SCH; ++t) { const unsigned lw = *(const unsigned*)(LA + base + (size_t)t * 1024), bw = *(const unsigned*)(BB + base + (size_t)t * 1024);
                h0 = __expf(bflo(lw)) * h0 + bflo(bw); h1 = __expf(bfhi(lw)) * h1 + bfhi(bw); y0[t] = h0; y1[t] = h1; } }
        { const size_t base = ((size_t)TA + (size_t)ck * SCH) * 1024 + cp * 2; const f32x2 c = *(const f32x2*)(CR + ((size_t)NCHUNK + ck) * 1024 + cp * 2); float h0 = c.x, h1 = c.y;
#pragma unroll
            for (int s = 0; s < SCH; ++s) { const int t = SCH - 1 - s; const unsigned lw = *(const unsigned*)(LA + base + (size_t)t * 1024), bw = *(const unsigned*)(BB + base + (size_t)t * 1024);
                h0 = __expf(bflo(lw)) * h0 + bflo(bw); h1 = __expf(bfhi(lw)) * h1 + bfhi(bw); y0[t] += h0; y1[t] += h1; } }
#pragma unroll
        for (int t = 0; t < SCH; ++t) { const size_t row = (size_t)ck * SCH + t; const unsigned gw = *(const unsigned*)(XG + row * 2048 + 1024 + cp * 2);
            *(unsigned*)(YG + row * 1024 + cp * 2) = pk2(y0[t] * gelu_tanh(bflo(gw)), y1[t] * gelu_tanh(bfhi(gw))); }
    }
}

__device__ __forceinline__ void qknorm_head(bf16_t* p, const float* g, bool rope, float cs, float sn, int lane) {
    const int i1 = lane + ((lane >= 32) ? 32 : 0), i2 = i1 + 32;
    const float x1 = bf2f(p[i1]), x2 = bf2f(p[i2]);
    const float rstd = 1.0f / sqrtf(wave_sum(x1 * x1 + x2 * x2) * (1.0f / 128.0f) + EPS);
    const float y1 = x1 * rstd * g[i1], y2 = x2 * rstd * g[i2];
    float o1 = y1, o2 = y2; if (rope) { o1 = y1 * cs - y2 * sn; o2 = y2 * cs + y1 * sn; }
    p[i1] = (bf16_t)f2bf(o1); p[i2] = (bf16_t)f2bf(o2);
}
__device__ __forceinline__ void qkrope_phase(Frame& F) {
    bf16_t* Q = (bf16_t*)(F.ws + WS_Q); bf16_t* KB = (bf16_t*)(F.ws + WS_KB);
    const float* qg = F.in[18]; const float* kg = F.in[19];
    const int j = F.lane & 31; const float freq = powf(10000.0f, -(float)j / 32.0f);
    for (int row = F.vcu * NWAVES + F.wave; row < TA; row += F.G * NWAVES) {
        if (row < TL) { const int b = row >> 13, t = row & 8191; const float pos = (F.lane < 32) ? (float)(t >> 6) : (float)(t & 63); float sn, cs; sincosf(pos * freq, &sn, &cs);
#pragma unroll 1
            for (int h = 0; h < 8; ++h) qknorm_head(Q + (size_t)row * 1024 + h * 128, qg, true, cs, sn, F.lane);
#pragma unroll 1
            for (int h = 0; h < 2; ++h) qknorm_head(KB + ((size_t)b * SKV + CL + t) * 256 + h * 128, kg, true, cs, sn, F.lane);
        } else { const int r2 = row - TL, b = r2 >> 8, t = r2 & 255;
#pragma unroll 1
            for (int h = 0; h < 2; ++h) qknorm_head(KB + ((size_t)b * SKV + t) * 256 + h * 128, kg, false, 1.f, 0.f, F.lane); }
    }
}

namespace attn {
constexpr int QBLK = 32, KVBLK = 64, LDQ = 1024, LDK = 256, LDO = 1024;
constexpr float SCALE = 0.088388347648318440f;
constexpr float THR = 8.f;
constexpr size_t SHM_V = KVBLK * HD * 2, SHM_K = KVBLK * HD * 2, SHM_ATTN = 2 * SHM_V + 2 * SHM_K + 8 * 64 * 4;
using s16x4 = __attribute__((ext_vector_type(4))) short;
#define KSWZ(row, colB) ((row) * 256 + ((colB) ^ (((row) & 7) << 4)))
#define SBAR() __builtin_amdgcn_sched_barrier(0)
__device__ __forceinline__ int crow(int r, int hi) { return (r & 3) + 8 * (r >> 2) + 4 * hi; }
__device__ __forceinline__ unsigned cvtpk(float lo, float hi) { unsigned r; asm volatile("v_cvt_pk_bf16_f32 %0, %1, %2" : "=v"(r) : "v"(lo), "v"(hi)); return r; }
__device__ __forceinline__ void partialSM(f32x16& p0, f32x16& p1, float& m_reg, float& mn, float& alpha) {
  constexpr float C = SCALE * 1.4426950408889634f;
  float pmax = p0[0]; for (int r = 1; r < 16; ++r) pmax = fmaxf(pmax, p0[r]); for (int r = 0; r < 16; ++r) pmax = fmaxf(pmax, p1[r]);
  { auto rr = __builtin_amdgcn_permlane32_swap(__float_as_uint(pmax), __float_as_uint(pmax), false, false);
    pmax = fmaxf(__uint_as_float(rr[0]), __uint_as_float(rr[1])); }
  if (__builtin_expect(__all(pmax - m_reg <= THR / SCALE), 1)) { mn = m_reg; alpha = 1.f; }
  else { mn = fmaxf(m_reg, pmax); alpha = __builtin_amdgcn_exp2f((m_reg - mn) * C); m_reg = mn; }
  float mnC = -mn * C;
  for (int r = 0; r < 16; ++r) p0[r] = fmaf(p0[r], C, mnC); for (int r = 0; r < 16; ++r) p1[r] = fmaf(p1[r], C, mnC);
  for (int r = 0; r < 16; ++r) p0[r] = __builtin_amdgcn_exp2f(p0[r]);
}
__device__ __forceinline__ void finishSM(f32x16& p0, f32x16& p1, float alpha, float& l_reg, bf16x8& pa0, bf16x8& pa1, bf16x8& pa2, bf16x8& pa3) {
  for (int r = 0; r < 16; ++r) p1[r] = __builtin_amdgcn_exp2f(p1[r]);
  float ps = 0; for (int r = 0; r < 16; ++r) ps += p0[r]; for (int r = 0; r < 16; ++r) ps += p1[r];
  { auto rr = __builtin_amdgcn_permlane32_swap(__float_as_uint(ps), __float_as_uint(ps), false, false);
    ps = __uint_as_float(rr[0]) + __uint_as_float(rr[1]); }
  l_reg = l_reg * alpha + ps;
#define PK4(P, BASE, OUT) do { unsigned a0 = cvtpk(P[BASE + 0], P[BASE + 1]), a1 = cvtpk(P[BASE + 2], P[BASE + 3]);   \
    unsigned b0 = cvtpk(P[BASE + 4], P[BASE + 5]), b1 = cvtpk(P[BASE + 6], P[BASE + 7]);                              \
    auto r0 = __builtin_amdgcn_permlane32_swap(a0, b0, false, false); auto r1 = __builtin_amdgcn_permlane32_swap(a1, b1, false, false); \
    u32x4 w = {r0[0], r1[0], r0[1], r1[1]}; OUT = *reinterpret_cast<bf16x8*>(&w); } while (0)
  PK4(p0, 0, pa0); PK4(p0, 8, pa1); PK4(p1, 0, pa2); PK4(p1, 8, pa3);
#undef PK4
}
__device__ __forceinline__ void qkt(f32x16& p0, f32x16& p1, const bf16_t* Ks, const bf16x8* qr, int r32, int hi) {
  p0 = f32x16{}; p1 = f32x16{};
  for (int d0 = 0; d0 < 8; ++d0) { int cb = (d0 * 16 + hi * 8) * 2;
    bf16x8 b0 = *reinterpret_cast<const bf16x8*>((const char*)Ks + KSWZ(r32, cb));
    bf16x8 b1 = *reinterpret_cast<const bf16x8*>((const char*)Ks + KSWZ(32 + r32, cb));
    p0 = __builtin_amdgcn_mfma_f32_32x32x16_bf16(b0, qr[d0], p0, 0, 0, 0);
    p1 = __builtin_amdgcn_mfma_f32_32x32x16_bf16(b1, qr[d0], p1, 0, 0, 0); }
}
__device__ __forceinline__ int v_st(int k, int c) { const int kk = (k & ~0xC) | ((k & 4) << 1) | ((k & 8) >> 1); return ((kk >> 3) * 4 + (c >> 5)) * 512 + ((kk & 7) * 32 + (c & 31)) * 2; }
__device__ __forceinline__ int v_rd_base(int lane) { return ((lane & 3) << 3) | (((lane >> 2) & 3) << 6) | (((lane >> 4) & 1) << 5) | (((lane >> 5) & 1) << 8); }
constexpr int v_rd_off(int d0, int ks, int half) { return d0 * 512 + ks * 4096 + half * 2048; }
template <int OFF> __device__ __forceinline__ s16x4 tr_read(int vb) {
  s16x4 r; asm volatile("ds_read_b64_tr_b16 %0, %1 offset:%2" : "=&v"(r) : "v"(vb), "i"(OFF) : "memory"); return r;
}
template <int D0> __device__ __forceinline__ void pv_one(f32x16& od, int vb, bf16x8 pa0, bf16x8 pa1, bf16x8 pa2, bf16x8 pa3) {
  const s16x4 l0 = tr_read<v_rd_off(D0, 0, 0)>(vb), h0 = tr_read<v_rd_off(D0, 0, 1)>(vb), l1 = tr_read<v_rd_off(D0, 1, 0)>(vb), h1 = tr_read<v_rd_off(D0, 1, 1)>(vb);
  const s16x4 l2 = tr_read<v_rd_off(D0, 2, 0)>(vb), h2 = tr_read<v_rd_off(D0, 2, 1)>(vb), l3 = tr_read<v_rd_off(D0, 3, 0)>(vb), h3 = tr_read<v_rd_off(D0, 3, 1)>(vb);
  asm volatile("s_waitcnt lgkmcnt(0)" ::: "memory"); SBAR();
#define PK(L, H) (bf16x8){L[0], L[1], L[2], L[3], H[0], H[1], H[2], H[3]}
  od = __builtin_amdgcn_mfma_f32_32x32x16_bf16(pa0, PK(l0, h0), od, 0, 0, 0);
  od = __builtin_amdgcn_mfma_f32_32x32x16_bf16(pa1, PK(l1, h1), od, 0, 0, 0);
  od = __builtin_amdgcn_mfma_f32_32x32x16_bf16(pa2, PK(l2, h2), od, 0, 0, 0);
  od = __builtin_amdgcn_mfma_f32_32x32x16_bf16(pa3, PK(l3, h3), od, 0, 0, 0);
#undef PK
}
__device__ __forceinline__ void pv_d0(f32x16* o, int vb, bf16x8 pa0, bf16x8 pa1, bf16x8 pa2, bf16x8 pa3) {
  pv_one<0>(o[0], vb, pa0, pa1, pa2, pa3); pv_one<1>(o[1], vb, pa0, pa1, pa2, pa3); pv_one<2>(o[2], vb, pa0, pa1, pa2, pa3); pv_one<3>(o[3], vb, pa0, pa1, pa2, pa3);
}
__device__ __forceinline__ void attn_dense_body(const bf16_t* __restrict__ Qb, const bf16_t* __restrict__ Kh, const bf16_t* __restrict__ Vh, bf16_t* __restrict__ Ob, int seq, char* lds) {
  const int tid = threadIdx.x, wid = tid >> 6, lane = tid & 63, r32 = lane & 31, hi = lane >> 5;
  bf16_t* V_lds = (bf16_t*)lds; bf16_t* K_lds = (bf16_t*)(lds + 2 * SHM_V);
  float* ws = (float*)(lds + 2 * SHM_V + 2 * SHM_K) + wid * 64; float* li_l = ws; float* al_l = ws + 32;
  float m_reg = -1e30f, l_reg = 0; f32x16 o[4] = {}; bf16x8 qr[8];
  const bf16_t* Qw = Qb + (long)(wid * QBLK + r32) * LDQ + hi * 8;
#pragma unroll
  for (int d0 = 0; d0 < 8; ++d0) qr[d0] = *reinterpret_cast<const bf16x8*>(Qw + d0 * 16);
  const int sr = tid >> 4, sc = (tid & 15) * 8, vst0 = v_st(sr, sc), vst1 = v_st(32 + sr, sc);
  const int vb0 = (int)(uintptr_t)V_lds + v_rd_base(lane);
  struct { bf16x8 vs0, vs1, ks0, ks1; } sr_[2];
#define SLOAD(i, k0) do { sr_[i].vs0 = *reinterpret_cast<const bf16x8*>(&Vh[(long)((k0) + sr) * LDK + sc]); sr_[i].vs1 = *reinterpret_cast<const bf16x8*>(&Vh[(long)((k0) + 32 + sr) * LDK + sc]); \
    sr_[i].ks0 = *reinterpret_cast<const bf16x8*>(&Kh[(long)((k0) + sr) * LDK + sc]); sr_[i].ks1 = *reinterpret_cast<const bf16x8*>(&Kh[(long)((k0) + 32 + sr) * LDK + sc]); } while (0)
#define SWRITE(b, i) do { *(bf16x8*)((char*)V_lds + (b) * SHM_V + vst0) = sr_[i].vs0;          \
    *(bf16x8*)((char*)V_lds + (b) * SHM_V + vst1) = sr_[i].vs1; int kc = sc * 2;               \
    *(bf16x8*)((char*)K_lds + (b) * SHM_K + KSWZ(sr, kc)) = sr_[i].ks0;                       \
    *(bf16x8*)((char*)K_lds + (b) * SHM_K + KSWZ(32 + sr, kc)) = sr_[i].ks1; } while (0)
#define SWAIT() asm volatile("s_waitcnt vmcnt(4)" ::: "memory")
#define RESC(a) do { if (__any((a) < 1.f)) { if (hi == 0) al_l[r32] = (a); asm volatile("s_waitcnt lgkmcnt(0)" ::: "memory"); \
    for (int d = 0; d < 4; ++d) for (int r = 0; r < 16; ++r) o[d][r] *= al_l[crow(r, hi)]; } } while (0)
  f32x16 pA0, pA1, pB0, pB1; float mnA, mnB, alA, alB; bf16x8 pa0, pa1, pa2, pa3; const int NT = seq / KVBLK;
  constexpr int SE = 0, SO = 1;
  SLOAD(SE, 0); asm volatile("s_waitcnt vmcnt(0)" ::: "memory"); SWRITE(0, SE); __syncthreads();
  qkt(pA0, pA1, K_lds, qr, r32, hi); partialSM(pA0, pA1, m_reg, mnA, alA);
  SLOAD(SO, KVBLK); if (2 < NT) SLOAD(SE, 2 * KVBLK);
  SWAIT(); SWRITE(1, SO); __syncthreads();
  for (int j = 1; j + 1 < NT; j += 2) {
    SBAR(); qkt(pB0, pB1, (bf16_t*)((char*)K_lds + SHM_K), qr, r32, hi);
    finishSM(pA0, pA1, alA, l_reg, pa0, pa1, pa2, pa3); SBAR();
    SLOAD(SO, (j + 2) * KVBLK); SBAR();
    pv_d0(o, vb0, pa0, pa1, pa2, pa3); partialSM(pB0, pB1, m_reg, mnB, alB);
    __syncthreads(); SWAIT(); SWRITE(0, SE);
    RESC(alB); __syncthreads();
    SBAR(); qkt(pA0, pA1, K_lds, qr, r32, hi);
    finishSM(pB0, pB1, alB, l_reg, pa0, pa1, pa2, pa3); SBAR();
    if (j + 3 < NT) SLOAD(SE, (j + 3) * KVBLK); SBAR();
    pv_d0(o, vb0 + (int)SHM_V, pa0, pa1, pa2, pa3); partialSM(pA0, pA1, m_reg, mnA, alA);
    __syncthreads(); SWAIT(); SWRITE(1, SO);
    RESC(alA); __syncthreads();
  }
  SBAR(); qkt(pB0, pB1, (bf16_t*)((char*)K_lds + SHM_K), qr, r32, hi);
  finishSM(pA0, pA1, alA, l_reg, pa0, pa1, pa2, pa3); SBAR();
  pv_d0(o, vb0, pa0, pa1, pa2, pa3); partialSM(pB0, pB1, m_reg, mnB, alB);
  __syncthreads(); RESC(alB);
  finishSM(pB0, pB1, alB, l_reg, pa0, pa1, pa2, pa3); SBAR();
  pv_d0(o, vb0 + (int)SHM_V, pa0, pa1, pa2, pa3);
  if (hi == 0) li_l[r32] = l_reg; asm volatile("s_waitcnt lgkmcnt(0)" ::: "memory");
  float rli[16];
#pragma unroll
  for (int r = 0; r < 16; ++r) rli[r] = __builtin_amdgcn_rcpf(li_l[crow(r, hi)]);
  bf16_t* Ow = Ob + (long)(wid * QBLK) * LDO;
#pragma unroll
  for (int r = 0; r < 16; ++r) { int orow = crow(r, hi);
    for (int d0 = 0; d0 < 4; ++d0) Ow[(long)orow * LDO + d0 * 32 + r32] = (bf16_t)f2bf(o[d0][r] * rli[r]); }
  __syncthreads();
#undef SLOAD
#undef SWRITE
#undef SWAIT
#undef RESC
}
#undef SBAR
}

__device__ __forceinline__ void attn_phase(Frame& F) {
    const bf16_t* Q = (const bf16_t*)(F.ws + WS_Q); const bf16_t* KB = (const bf16_t*)(F.ws + WS_KB); const bf16_t* VB = (const bf16_t*)(F.ws + WS_VB); bf16_t* O = (bf16_t*)(F.ws + WS_O);
    for (int i = 0; i < 2; ++i) {
        const int L = i * F.G + F.vcu; if (L >= 512) break;
        const int xcd = (L % F.G) / 32, c = (L % F.G) % 32, grp = xcd >> 1, b = grp >> 1, kv = grp & 1, h = kv * 4 + (xcd & 1) * 2 + (L / F.G), qb = c;
        attn::attn_dense_body(Q + ((size_t)b * SEQ + qb * 256) * 1024 + h * 128, KB + (size_t)b * SKV * 256 + kv * 128, VB + (size_t)b * SKV * 256 + kv * 128,
                              O + ((size_t)b * SEQ + qb * 256) * 1024 + h * 128, SKV, (char*)F.lds);
    }
}

__device__ __forceinline__ void moe_gather_phase(Frame& F) {
    LAS int* ps = (LAS int*)F.lds;
    if (F.tid == 0) { int acc = 0;
        for (int e = 0; e < 8; ++e) { const int c = (int)__hip_atomic_load((unsigned*)(F.ws + WS_CTL) + CW_GCNT + e, RLX_AGENT); const int t = (c + 255) >> 8; ps[e] = acc * 256; ps[8 + e] = c; ps[16 + e] = t;
            if (F.vcu == 0) for (int q = 0; q < t; ++q) ((int*)(F.ws + WS_TILEE))[acc + q] = e;
            acc += t; }
        if (F.vcu == 0) ((int*)(F.ws + WS_TILEE))[200] = acc; }
    __syncthreads();
    const bf16_t* H2 = (const bf16_t*)(F.ws + WS_H2); bf16_t* XGt = (bf16_t*)(F.ws + WS_XGATH);
    const int* TE = (const int*)(F.ws + WS_TOKE); const int* RK = (const int*)(F.ws + WS_RANK); int* DS = (int*)(F.ws + WS_DEST);
    for (int s = F.vcu * NWAVES + F.wave; s < 2 * TL; s += F.G * NWAVES) {
        const int tok = s >> 1, k = s & 1; const int e = (TE[tok] >> (8 * k)) & 0xff; const int dest = ps[e] + RK[s];
        if (F.lane == 0) DS[s] = dest;
        const u32x4* src = (const u32x4*)(H2 + (size_t)tok * 1024); u32x4* dst = (u32x4*)(XGt + (size_t)dest * 1024);
        dst[F.lane] = src[F.lane]; dst[64 + F.lane] = src[64 + F.lane];
    }
    for (int p = F.vcu * NWAVES + F.wave; p < 8 * 256; p += F.G * NWAVES) {
        const int e = p >> 8, j = p & 255; if (ps[8 + e] + j < ps[16 + e] * 256) { u32x4* dst = (u32x4*)(XGt + (size_t)(ps[e] + ps[8 + e] + j) * 1024); const u32x4 z = {0u, 0u, 0u, 0u}; dst[F.lane] = z; dst[64 + F.lane] = z; }
    }
}
__device__ __forceinline__ void combine_phase(Frame& F) {
    const bf16_t* Y = (const bf16_t*)(F.ws + WS_Y); const int* DS = (const int*)(F.ws + WS_DEST); const float* TW = (const float*)(F.ws + WS_TOKW);
    const float* modl = (const float*)(F.ws + WS_MOD) + 3 * 6144; const float* fg = F.in[28];
    for (int row = F.vcu * NWAVES + F.wave; row < TL; row += F.G * NWAVES) {
        const float* g2 = modl + (row >> 13) * 6144 + 5 * 1024; const int d0 = DS[row * 2], d1 = DS[row * 2 + 1]; const float w0 = TW[row * 2], w1 = TW[row * 2 + 1];
        float* xr = F.out + (size_t)row * 1024; f32x4 v[4]; float ss = 0.f;
#pragma unroll
        for (int j = 0; j < 4; ++j) { const int c = 4 * F.lane + 256 * j; const u32x2 ya = *(const u32x2*)(Y + (size_t)d0 * 1024 + c), yb = *(const u32x2*)(Y + (size_t)d1 * 1024 + c);
            const f32x4 fa = {bflo(ya.x), bfhi(ya.x), bflo(ya.y), bfhi(ya.y)}, fb = {bflo(yb.x), bfhi(yb.x), bflo(yb.y), bfhi(yb.y)};
            v[j] = *(const f32x4*)(xr + c) + *(const f32x4*)(g2 + c) * (fa * w0 + fb * w1);
            ss += (v[j][0] * v[j][0] + v[j][1] * v[j][1]) + (v[j][2] * v[j][2] + v[j][3] * v[j][3]); }
        const float rstd = 1.0f / sqrtf(wave_sum(ss) * (1.0f / 1024.0f) + EPS);
#pragma unroll
        for (int j = 0; j < 4; ++j) { const int c = 4 * F.lane + 256 * j; *(f32x4*)(xr + c) = v[j] * rstd * *(const f32x4*)(fg + c); }
    }
}

constexpr int N_PHASES = 22;
struct Args { const float* in[29]; float* out; unsigned char* ws; int ph_lo, ph_hi, li, pad; };

__global__ void __launch_bounds__(NTHR, 2) fwd_kernel(Args args) {
    extern __shared__ __attribute__((aligned(16))) unsigned char lds[];
    Frame F;
    F.lds = lds; F.tid = threadIdx.x; F.lane = F.tid & 63; F.wave = __builtin_amdgcn_readfirstlane(F.tid >> 6);
    F.G = gridDim.x; { const int bx = blockIdx.x; F.vcu = (F.G % 8 == 0) ? (bx % 8) * (F.G / 8) + bx / 8 : bx; }
#pragma unroll
    for (int i = 0; i < 29; ++i) F.in[i] = args.in[i];
    F.out = args.out; F.ws = args.ws;
    unsigned char* ws = args.ws;
    const float* MOD = (const float*)(ws + WS_MOD);
    for (int u = F.tid; u < (LDS_BYTES - LDSCTL_OFF) / 4; u += NTHR) ((LAS unsigned*)(lds + LDSCTL_OFF))[u] = 0u;
    __syncthreads();
    XcdBarrier bar; bar.bar = (unsigned*)(ws + WS_CTL) + CW_BAR; bar.x = 0; bar.st = nullptr;
    if (MK_SINGLE) bar = xcd_barrier_post((unsigned*)(ws + WS_CTL) + CW_BAR, (volatile LAS unsigned*)(lds + MISC_OFF) + 8);
    const int lo = args.ph_lo, hi = args.ph_hi;
#define IN(k) (lo <= (k) && (k) < hi)
#define SEAM(k) do { if (IN((k) + 1)) { if (MK_SINGLE) xcd_barrier(bar); } } while (0)

    if (IN(0)) { p0_prologue(F); SEAM(0); }
    if (IN(1)) { modnorm_phase<false>(F, F.in[0], F.in[2], TA, F.in[6], MOD, 0, 1, (bf16_t*)(ws + WS_H)); SEAM(1); }
    if (IN(2)) { const EpiStoreBf16 E{(bf16_t*)(ws + WS_XG), 2048};
        for (int L = F.vcu; L < (66 * 8); L += F.G) { const Unit u{L % 66, L / 66}; sgemm_unit(lds, (const bf16_t*)(ws + WS_H) + (size_t)u.pm * 256 * 1024, 1024, (const bf16_t*)(ws + WS_W_IN) + (size_t)u.pn * 256 * 1024, 1024, 1024, E, u); }
        SEAM(2); }
    if (IN(3)) { conv_phase(F); SEAM(3); }
    if (IN(4)) {
        for (int L = F.vcu; L < (66 * 8 * 2); L += F.G) { const int pm = L % 66, blk = (L / 66) % 8, d = L / (66 * 8); const Unit u{pm, d};
            const EpiGates E{(const bf16_t*)(ws + WS_XC), (bf16_t*)(ws + WS_LA), (bf16_t*)(ws + WS_BB), F.in[12], F.in[14], (const float*)(ws + WS_C8), blk};
            sgemm_unit(lds, (const bf16_t*)(ws + WS_XC) + (size_t)pm * 256 * 1024 + blk * 128, 1024, (const bf16_t*)(ws + WS_W_GATE) + (size_t)(blk * 512 + d * 256) * 128, 128, 128, E, u); }
        SEAM(4); }
    if (IN(5)) { scan_agg_phase(F); SEAM(5); }
    if (IN(6)) { scan_carry_phase(F); SEAM(6); }
    if (IN(7)) { scan_apply_phase(F); SEAM(7); }
    if (IN(8)) { const EpiResid E{F.in[0], F.out, F.in[2], (float*)(ws + WS_CTXR), MOD, 2048};
        for (int L = F.vcu; L < (66 * 4); L += F.G) { const Unit u{L % 66, L / 66}; sgemm_unit(lds, (const bf16_t*)(ws + WS_YG) + (size_t)u.pm * 256 * 1024, 1024, (const bf16_t*)(ws + WS_W_OUT) + (size_t)u.pn * 256 * 1024, 1024, 1024, E, u); }
        SEAM(8); }
    if (IN(9)) { modnorm_phase<false>(F, F.out, (const float*)(ws + WS_CTXR), TA, F.in[7], MOD, 3, 4, (bf16_t*)(ws + WS_H)); SEAM(9); }
    if (IN(10)) { const EpiSwiglu E{(bf16_t*)(ws + WS_HID), DFF};
        for (int L = F.vcu; L < (66 * 22); L += F.G) { const Unit u{L % 66, L / 66}; sgemm_unit(lds, (const bf16_t*)(ws + WS_H) + (size_t)u.pm * 256 * 1024, 1024, (const bf16_t*)(ws + WS_W13) + (size_t)u.pn * 256 * 1024, 1024, 1024, E, u); }
        SEAM(10); }
    if (IN(11)) { const EpiResid E{F.out, F.out, (const float*)(ws + WS_CTXR), (float*)(ws + WS_CTXR), MOD, 5120};
        for (int L = F.vcu; L < (66 * 4); L += F.G) { const Unit u{L % 66, L / 66}; sgemm_unit(lds, (const bf16_t*)(ws + WS_HID) + (size_t)u.pm * 256 * DFF, DFF, (const bf16_t*)(ws + WS_W2) + (size_t)u.pn * 256 * DFF, DFF, DFF, E, u); }
        SEAM(11); }
    if (IN(12)) { modnorm_phase<false>(F, F.out, (const float*)(ws + WS_CTXR), TA, F.in[6] + 1024, MOD + 3 * 6144, 0, 1, (bf16_t*)(ws + WS_H)); SEAM(12); }
    if (IN(13)) { const EpiQKV E{(bf16_t*)(ws + WS_Q), (bf16_t*)(ws + WS_KB), (bf16_t*)(ws + WS_VB)};
        for (int L = F.vcu; L < (66 * 6); L += F.G) { const Unit u{L % 66, L / 66}; if (!(u.pm >= 64 && u.pn < 4)) sgemm_unit(lds, (const bf16_t*)(ws + WS_H) + (size_t)u.pm * 256 * 1024, 1024, (const bf16_t*)(ws + WS_W_QKV) + (size_t)u.pn * 256 * 1024, 1024, 1024, E, u); }
        SEAM(13); }
    if (IN(14)) { qkrope_phase(F); SEAM(14); }
    if (IN(15)) { attn_phase(F); SEAM(15); }
    if (IN(16)) { const EpiResid E{F.out, F.out, nullptr, nullptr, MOD + 3 * 6144, 2048};
        for (int L = F.vcu; L < (64 * 4); L += F.G) { const Unit u{L % 64, L / 64}; sgemm_unit(lds, (const bf16_t*)(ws + WS_O) + (size_t)u.pm * 256 * 1024, 1024, (const bf16_t*)(ws + WS_W_O) + (size_t)u.pn * 256 * 1024, 1024, 1024, E, u); }
        SEAM(16); }
    if (IN(17)) { modnorm_phase<true>(F, F.out, nullptr, TL, F.in[7] + 1024, MOD + 3 * 6144, 3, 4, (bf16_t*)(ws + WS_H2)); SEAM(17); }
    if (IN(18)) { moe_gather_phase(F); SEAM(18); }
    if (IN(19)) { const int* TLE = (const int*)(ws + WS_TILEE); const int nMt = TLE[200]; const EpiSwiglu E{(bf16_t*)(ws + WS_MHID), DFE};
        for (int L = F.vcu; L < (nMt * 28); L += F.G) { const Unit u{L % nMt, L / nMt}; const int e = TLE[u.pm];
            sgemm_unit(lds, (const bf16_t*)(ws + WS_XGATH) + (size_t)u.pm * 256 * 1024, 1024, (const bf16_t*)(ws + WS_MW13) + ((size_t)e * 2 * DFE + u.pn * 256) * 1024, 1024, 1024, E, u); }
        SEAM(19); }
    if (IN(20)) { const int* TLE = (const int*)(ws + WS_TILEE); const int nMt = TLE[200]; const EpiStoreBf16 E{(bf16_t*)(ws + WS_Y), 1024};
        for (int L = F.vcu; L < (nMt * 4); L += F.G) { const Unit u{L % nMt, L / nMt}; const int e = TLE[u.pm];
            sgemm_unit(lds, (const bf16_t*)(ws + WS_MHID) + (size_t)u.pm * 256 * DFE, DFE, (const bf16_t*)(ws + WS_MW2) + ((size_t)e * 1024 + u.pn * 256) * DFE, DFE, DFE, E, u); }
        SEAM(20); }
    if (IN(21)) { combine_phase(F); }
#undef IN
#undef SEAM
}

extern "C" void kernel_launch(void* const* d_in, const int* in_sizes, int n_in, void* d_out, int out_size, void* d_ws, size_t ws_size, hipStream_t stream) {
    static int grid = 0;
    if (grid == 0) {
        if (n_in != 29 || out_size != TL * D || ws_size < WS_END) { fprintf(stderr, "kernel_launch: unexpected shapes: n_in %d out %d ws %zu (need %zu)\n", n_in, out_size, ws_size, (size_t)WS_END); grid = -1; return; }
        int dev = 0, cus = 0;
        if (hipGetDevice(&dev) != hipSuccess || hipDeviceGetAttribute(&cus, hipDeviceAttributeMultiprocessorCount, dev) != hipSuccess) { grid = -1; return; }
        if (hipFuncSetAttribute((const void*)fwd_kernel, hipFuncAttributeMaxDynamicSharedMemorySize, LDS_BYTES) != hipSuccess) { fprintf(stderr, "kernel_launch: hipFuncSetAttribute failed\n"); grid = -1; return; }
        int per_cu = 0; (void)hipOccupancyMaxActiveBlocksPerMultiprocessor(&per_cu, (const void*)fwd_kernel, NTHR, LDS_BYTES); (void)hipGetLastError();
        grid = cus;
    }
    if (grid < 0) return;
    (void)hipMemsetAsync((char*)d_ws + WS_CTL, 0, CTL_ZERO_BYTES, stream);
    Args a{};
    for (int i = 0; i < 29; ++i) a.in[i] = (const float*)d_in[i];
    a.out = (float*)d_out; a.ws = (unsigned char*)d_ws;
#if MK_SINGLE
    a.ph_lo = 0; a.ph_hi = N_PHASES; a.li = 0;
    hipLaunchKernelGGL(fwd_kernel, dim3(grid), dim3(NTHR), LDS_BYTES, stream, a);
#else
    for (int p = 0; p < N_PHASES; ++p) { a.ph_lo = p; a.ph_hi = p + 1; a.li = p; hipLaunchKernelGGL(fwd_kernel, dim3(grid), dim3(NTHR), LDS_BYTES, stream, a); }
#endif
    const hipError_t le = hipPeekAtLastError();
    if (le != hipSuccess) fprintf(stderr, "kernel_launch: launch failed: %s\n", hipGetErrorName(le));
}
```

```cpp
#include <hip/hip_runtime.h>
#include <hip/hip_bf16.h>
#include <cstdio>
#include <cstdint>

#ifndef MK_SINGLE
#define MK_SINGLE 1
#endif

#define GAS __attribute__((address_space(1)))
#define LAS __attribute__((address_space(3)))
typedef unsigned short bf16_t;
typedef short bf16x8 __attribute__((ext_vector_type(8)));
typedef float f32x4 __attribute__((ext_vector_type(4)));
typedef float f32x2 __attribute__((ext_vector_type(2)));
typedef float f32x16 __attribute__((ext_vector_type(16)));
typedef unsigned u32x4 __attribute__((ext_vector_type(4)));
typedef unsigned u32x2 __attribute__((ext_vector_type(2)));
typedef GAS unsigned gu32;

constexpr int D = 1024, NB = 2, SEQ = 8192, CL = 256;
constexpr int TL = NB * SEQ, TC = NB * CL, TA = TL + TC;
constexpr int DFF = 2816, NE = 8, DFE = 3584;
constexpr int NQKV = 1536, HD = 128, SKV = CL + SEQ;
constexpr float EPS = 1e-6f;
constexpr int NWAVES = 8, NTHR = 512;
constexpr int SCH = 32, NCHUNK = TA / SCH;
constexpr int MAXMT = 135;

constexpr size_t MiB = 1u << 20;
constexpr size_t WS_CTL = 0, CTL_ZERO_BYTES = 1 * MiB;
constexpr size_t WS_MOD = 1 * MiB;
constexpr size_t WS_C8 = WS_MOD + 160 * 1024;
constexpr size_t WS_TOKE = WS_MOD + 192 * 1024;
constexpr size_t WS_TOKW = WS_MOD + 256 * 1024;
constexpr size_t WS_RANK = WS_MOD + 384 * 1024;
constexpr size_t WS_DEST = WS_MOD + 512 * 1024;
constexpr size_t WS_TILEE = WS_MOD + 640 * 1024;
constexpr size_t WS_CTXR = 2 * MiB;
constexpr size_t WS_W_IN = 4 * MiB, WS_W_GATE = 8 * MiB, WS_W_OUT = 9 * MiB, WS_W_QKV = 11 * MiB, WS_W_O = 14 * MiB, WS_W13 = 16 * MiB, WS_W2 = 27 * MiB;
constexpr size_t WS_MW13 = 33 * MiB, WS_MW2 = 145 * MiB;
constexpr size_t WS_H = 201 * MiB;
constexpr size_t WS_XG = 234 * MiB;
constexpr size_t WS_XC = 300 * MiB, WS_YG = 300 * MiB;
constexpr size_t WS_LA = 333 * MiB, WS_BB = 399 * MiB;
constexpr size_t WS_AGGP = 465 * MiB, WS_AGGQ = 470 * MiB, WS_CARRY = 475 * MiB;
constexpr size_t WS_HID = 234 * MiB;
constexpr size_t WS_Q = 234 * MiB, WS_KB = 266 * MiB, WS_VB = 275 * MiB, WS_O = 284 * MiB;
constexpr size_t WS_H2 = 320 * MiB;
constexpr size_t WS_XGATH = 201 * MiB, WS_Y = 201 * MiB;
constexpr size_t WS_MHID = 269 * MiB;
constexpr size_t WS_END = WS_MHID + (size_t)MAXMT * 256 * DFE * 2;
static_assert(WS_END <= 531788800ull, "workspace map exceeds sum(inputs)");
constexpr int CW_GCNT = 64;
constexpr int CW_BAR = 4096;

constexpr int RING_BYTES = 131072;
constexpr int LDSCTL_OFF = RING_BYTES, MISC_OFF = LDSCTL_OFF + 320;
constexpr int LDS_BYTES = 147456;

#define RLX_AGENT __ATOMIC_RELAXED, __HIP_MEMORY_SCOPE_AGENT
__device__ __forceinline__ unsigned f2bf(float f) { unsigned u = __builtin_bit_cast(unsigned, f); return (u + 0x7fffu + ((u >> 16) & 1u)) >> 16; }
__device__ __forceinline__ unsigned pk2(float lo, float hi) { return f2bf(lo) | (f2bf(hi) << 16); }
__device__ __forceinline__ float bf2f(unsigned short b) { return __builtin_bit_cast(float, (unsigned)b << 16); }
__device__ __forceinline__ float bflo(unsigned w) { return __builtin_bit_cast(float, w << 16); }
__device__ __forceinline__ float bfhi(unsigned w) { return __builtin_bit_cast(float, w & 0xffff0000u); }
__device__ __forceinline__ float wave_sum(float v) {
#pragma unroll
    for (int o = 1; o < 64; o <<= 1) v += __shfl_xor(v, o);
    return v;
}
__device__ __forceinline__ float sigmoidf_(float x) { return 1.0f / (1.0f + __expf(-x)); }
__device__ __forceinline__ float siluf_(float x) { return x / (1.0f + __expf(-x)); }
__device__ __forceinline__ float gelu_tanh(float x) { const float u = 0.7978845608028654f * (x + 0.044715f * x * x * x); return 0.5f * x * (1.0f + tanhf(u)); }

#define XB_TMO      128
#define XB_XCNT(j)  (256  + 64 * (j))
#define XB_XSUB(j)  (1280 + 64 * (j))
#define XB_XGEN(j)  (2304 + 64 * (j))
#define XB_TOP      3328
#define XB_TOPGEN   3392
#define XCD_BAR_WORDS 3456
#define XB_SPIN_CAP (1u << 18)
__device__ __forceinline__ unsigned xb_ld(unsigned* p)              { return __hip_atomic_load(p, __ATOMIC_RELAXED, __HIP_MEMORY_SCOPE_AGENT); }
__device__ __forceinline__ unsigned xb_add(unsigned* p, unsigned v) { return __hip_atomic_fetch_add(p, v, __ATOMIC_RELAXED, __HIP_MEMORY_SCOPE_AGENT); }
__device__ __forceinline__ unsigned xb_xcc_id() { return (unsigned)__builtin_amdgcn_s_getreg((3 << 11) | 20) & 0xFu; }
#define XB_SPIN(cond, bar) do { unsigned _sp = 0; while (cond) { __builtin_amdgcn_s_sleep(1); \
    if ((++_sp & 255u) == 0u) { if (xb_ld(&(bar)[XB_TMO])) break; if (_sp > XB_SPIN_CAP) { atomicAdd(&(bar)[XB_TMO], 1u); break; } } } } while (0)
struct XcdBarrier { unsigned* bar; unsigned x; volatile LAS unsigned* st; };
__device__ __forceinline__ XcdBarrier xcd_barrier_post(unsigned* bar, volatile LAS unsigned* st) {
    XcdBarrier b; b.bar = bar; b.x = xb_xcc_id(); b.st = st;
    if (threadIdx.x == 0) (void)xb_add(&bar[XB_XCNT(b.x)], 1u);
    return b;
}
__device__ __forceinline__ void xcd_barrier_complete(unsigned* bar, unsigned x, unsigned& nloc, unsigned& nx) {
    const unsigned G = gridDim.x * gridDim.y * gridDim.z;
    unsigned sum, cnt, mine, sp = 0u;
    for (;;) {
        sum = 0u; cnt = 0u; mine = 0u;
#pragma unroll
        for (unsigned j = 0; j < 16; ++j) { const unsigned c = xb_ld(&bar[XB_XCNT(j)]); sum += c; cnt += (c > 0u) ? 1u : 0u; mine = (j == x) ? c : mine; }
        if (sum == G) break;
        __builtin_amdgcn_s_sleep(1);
        if ((++sp & 255u) == 0u) { if (xb_ld(&bar[XB_TMO])) break; if (sp > XB_SPIN_CAP) { atomicAdd(&bar[XB_TMO], 1u); break; } }
    }
    nloc = mine > 0u ? mine : 1u; nx = cnt > 0u ? cnt : 1u;
}
__device__ __forceinline__ void xcd_barrier(const XcdBarrier& b) {
    asm volatile("s_waitcnt vmcnt(0)" ::: "memory");
    __syncthreads();
    if (threadIdx.x == 0) {
        unsigned* bar = b.bar;
        __builtin_amdgcn_s_waitcnt(0);
        unsigned nloc = b.st[0], nx = b.st[1];
        if (nloc == 0u) { xcd_barrier_complete(bar, b.x, nloc, nx); b.st[0] = nloc; b.st[1] = nx; }
        const unsigned old = xb_add(&bar[XB_XSUB(b.x)], 1u);
        const unsigned gen = old / nloc;
        if (old + 1u == (gen + 1u) * nloc) {
            __builtin_amdgcn_fence(__ATOMIC_RELEASE, "agent");
            asm volatile("s_waitcnt vmcnt(0)" ::: "memory");
            const unsigned og = xb_add(&bar[XB_TOP], 1u);
            const unsigned tg = og / nx;
            if (og + 1u == (tg + 1u) * nx) xb_add(&bar[XB_TOPGEN], 1u);
            else XB_SPIN(xb_ld(&bar[XB_TOPGEN]) == tg, bar);
            __builtin_amdgcn_fence(__ATOMIC_ACQUIRE, "agent");
            xb_add(&bar[XB_XGEN(b.x)], 1u);
            asm volatile("s_waitcnt vmcnt(0)" ::: "memory");
        } else {
            XB_SPIN(xb_ld(&bar[XB_XGEN(b.x)]) == gen, bar);
            __builtin_amdgcn_fence(__ATOMIC_ACQUIRE, "agent");
            asm volatile("s_waitcnt vmcnt(0)" ::: "memory");
        }
    }
    __syncthreads();
}

namespace pg8 {
#define PG8_LAS __attribute__((address_space(3)))
typedef unsigned short bf16_t;
typedef short bf16x8 __attribute__((ext_vector_type(8)));
typedef float f32x4 __attribute__((ext_vector_type(4)));
typedef unsigned u32x4 __attribute__((ext_vector_type(4)));
constexpr int BM = 256, BK = 64, HALF = 128, HTB = HALF * BK * 2  , STAGE_BYTES = 8 * HTB, NXCD = 8, WGM = 8;

__host__ __device__ __forceinline__ int lds_byte(int r, int c) { const int st = (r >> 4) * 2 + (c >> 5), rr = r & 15, cc = c & 31, ob = rr * 64 + cc * 2; return st * 1024 + (ob ^ (((ob >> 9) & 1) << 5)); }
__host__ __device__ __forceinline__ void stage_rc(int b, int& R, int& C) { const int st = b / 1024, sb = b % 1024, swz = sb ^ (((sb >> 9) & 1) << 5); R = (st >> 1) * 16 + swz / 64; C = (st & 1) * 32 + (swz % 64) / 2; }
__host__ __device__ __forceinline__ int perm32(int rho) { const int n = rho >> 4, i = rho & 15; return 8 * (i >> 2) + 4 * n + (i & 3); }

struct Unit { int pm, pn; };
struct Gemm { const bf16_t* A; const bf16_t* Bt; int M, N, K; };

struct StaticOrder {
    int nM, nN, nwg, G, c;
    __host__ __device__ void init(int M, int N, int G_, int c_) { nM = M / BM; nN = N / BM; nwg = nM * nN; G = G_; c = c_; }
    __host__ __device__ bool next(int i, Unit& u) const {
        const long L = (long)i * G + c; if (L >= nwg) return false;
        int wgid = (int)L; { const int q = nwg / NXCD, r = nwg % NXCD, xcd = wgid % NXCD, off = wgid / NXCD; wgid = (xcd < r ? xcd * (q + 1) : r * (q + 1) + (xcd - r) * q) + off; }
        const int nig = WGM * nN, gid = wgid / nig, fm = gid * WGM, gsz = (nM - fm) < WGM ? (nM - fm) : WGM;
        u.pm = fm + ((wgid % nig) % gsz); u.pn = (wgid % nig) / gsz; return true;
    }
    __device__ __forceinline__ void a_ready(const Unit&) const {}
    __device__ __forceinline__ void done(const Unit&) const {}
};

__device__ __forceinline__ unsigned cvt_pk_bf16(float lo, float hi) { unsigned r; asm volatile("v_cvt_pk_bf16_f32 %0, %1, %2" : "=v"(r) : "v"(lo), "v"(hi)); return r; }
template <class Epi, class Sched, bool ALIGN_EPI = false, bool SP2 = false>
__device__ __forceinline__ void gemm_phase(PG8_LAS unsigned char* lds, const Gemm g, const Sched& S, const Epi& E) {
    const int tid = threadIdx.x, wid = __builtin_amdgcn_readfirstlane(tid >> 6), lane = tid & 63, wr = wid >> 2, wc = wid & 3, fr = lane & 15, fq = lane >> 4;
    const int K = g.K, nt = K / BK;
    unsigned voffA[2], voffB[2];
#pragma unroll
    for (int i = 0; i < 2; ++i) { int R, C; stage_rc(tid * 16 + i * 8192, R, C); const int Rb = Epi::PERM ? ((R & ~31) + perm32(R & 31)) : R;
        voffA[i] = (unsigned)(R * K + C) * 2u; voffB[i] = (unsigned)(Rb * K + C) * 2u; }
    const size_t kstep = (size_t)(BK * 2);
    const size_t hstep = (size_t)HALF * K * 2;
    const size_t tstep = 2 * hstep;
    const unsigned ldsw = (unsigned)wid * 1024u;
    const int aoff = lds_byte(wr * 64 + fr, fq * 8), boff = lds_byte(wc * 32 + fr, fq * 8);
#define PG8_SA(b, h) (((b) * 2 + (h)) * HTB)
#define PG8_SB(b, h) ((4 + (b) * 2 + (h)) * HTB)
#define PG8_STAGE(bufoff, gbase, voff) do { _Pragma("unroll") for (int _i = 0; _i < 2; ++_i) \
        __builtin_amdgcn_global_load_lds((const unsigned*)((const char*)(gbase) + (voff)[_i]), (PG8_LAS unsigned*)(lds + (bufoff) + ldsw + _i * 8192), 16, 0, 0); } while (0)
#define PG8_LDA(dst, b, h) do { _Pragma("unroll") for (int m = 0; m < 4; ++m) _Pragma("unroll") for (int k = 0; k < 2; ++k) dst[m][k] = *(const PG8_LAS bf16x8*)(lds + PG8_SA(b, h) + aoff + m * 2048 + k * 1024); } while (0)
#define PG8_LDB(dst, b, h) do { _Pragma("unroll") for (int n = 0; n < 2; ++n) _Pragma("unroll") for (int k = 0; k < 2; ++k) dst[n][k] = *(const PG8_LAS bf16x8*)(lds + PG8_SB(b, h) + boff + n * 2048 + k * 1024); } while (0)
#define PG8_MMA(ai, bj, At, Bt) do { __builtin_amdgcn_s_setprio(1); _Pragma("unroll") for (int m = 0; m < 4; ++m) _Pragma("unroll") for (int n = 0; n < 2; ++n) _Pragma("unroll") for (int k = 0; k < 2; ++k) \
        acc[ai][bj][m][n] = __builtin_amdgcn_mfma_f32_16x16x32_bf16(Bt[n][k], At[m][k], acc[ai][bj][m][n], 0, 0, 0); __builtin_amdgcn_s_setprio(0); } while (0)
#define PG8_WAIT_V(n) asm volatile("s_waitcnt vmcnt(" #n ")" ::: "memory")
#define PG8_WAIT_L(n) asm volatile("s_waitcnt lgkmcnt(" #n ")" ::: "memory")
#define PG8_BAR __builtin_amdgcn_s_barrier()
#define PG8_SCHED __builtin_amdgcn_sched_barrier(0)
    Unit cur, nxt; int ui = 0;
    if (!S.next(0, cur)) return;
    f32x4 acc[2][2][4][2];
#pragma unroll
    for (int a = 0; a < 2; ++a)
#pragma unroll
        for (int b = 0; b < 2; ++b)
#pragma unroll
            for (int m = 0; m < 4; ++m)
#pragma unroll
                for (int n = 0; n < 2; ++n) acc[a][b][m][n] = (f32x4){0.f, 0.f, 0.f, 0.f};
    bf16x8 At[4][2], B0[2][2], B1[2][2];
    const char* cA = (const char*)g.A + (size_t)cur.pm * tstep; const char* cB = (const char*)g.Bt + (size_t)cur.pn * tstep;
    S.a_ready(cur);
    if constexpr (SP2) {
        PG8_STAGE(PG8_SB(0, 0), cB, voffB); PG8_STAGE(PG8_SB(0, 1), cB + hstep, voffB); PG8_STAGE(PG8_SA(0, 0), cA, voffA); PG8_STAGE(PG8_SA(0, 1), cA + hstep, voffA);
        if (wr == 1) PG8_BAR;
        PG8_WAIT_V(2); PG8_BAR;
        PG8_STAGE(PG8_SB(1, 0), cB + kstep, voffB); PG8_STAGE(PG8_SA(1, 0), cA + kstep, voffA); PG8_STAGE(PG8_SB(1, 1), cB + hstep + kstep, voffB);
        PG8_WAIT_V(6); PG8_BAR;
    } else {
        PG8_STAGE(PG8_SB(0, 0), cB, voffB); PG8_STAGE(PG8_SA(0, 0), cA, voffA); PG8_STAGE(PG8_SB(0, 1), cB + hstep, voffB); PG8_STAGE(PG8_SA(0, 1), cA + hstep, voffA);
        if (wr == 1) PG8_BAR;
        PG8_WAIT_V(4); PG8_BAR;
        PG8_STAGE(PG8_SB(1, 0), cB + kstep, voffB); PG8_STAGE(PG8_SA(1, 0), cA + kstep, voffA); PG8_STAGE(PG8_SB(1, 1), cB + hstep + kstep, voffB);
        PG8_WAIT_V(6); PG8_BAR;
    }
    for (;;) {
        const bool has_next = S.next(ui + 1, nxt);
        const char* nA = has_next ? (const char*)g.A + (size_t)nxt.pm * tstep : cA; const char* nB = has_next ? (const char*)g.Bt + (size_t)nxt.pn * tstep : cB;
        for (int t = 0; t < nt; t += 2) {
            const bool last = (t == nt - 2);
            const char* a1 = cA + (size_t)(t + 1) * kstep;
            const char* a2 = last ? nA : cA + (size_t)(t + 2) * kstep; const char* b2 = last ? nB : cB + (size_t)(t + 2) * kstep;
            const char* a3 = a2 + kstep; const char* b3 = b2 + kstep;
            if (last && has_next) S.a_ready(nxt);
            if constexpr (SP2) {
            PG8_LDB(B0, 0, 0); PG8_LDB(B1, 0, 1); PG8_SCHED; PG8_LDA(At, 0, 0); PG8_STAGE(PG8_SA(1, 1), a1 + hstep, voffA);
            PG8_WAIT_V(8); PG8_WAIT_L(0); PG8_BAR; PG8_MMA(0, 0, At, B0); PG8_MMA(0, 1, At, B1); PG8_BAR; PG8_SCHED;
            PG8_LDA(At, 0, 1); PG8_STAGE(PG8_SB(0, 0), b2, voffB); PG8_STAGE(PG8_SB(0, 1), b2 + hstep, voffB); PG8_STAGE(PG8_SA(0, 0), a2, voffA);
            PG8_WAIT_V(8); PG8_WAIT_L(0); PG8_BAR; PG8_MMA(1, 0, At, B0); PG8_MMA(1, 1, At, B1); PG8_BAR; PG8_SCHED;
            PG8_LDB(B0, 1, 0); PG8_LDB(B1, 1, 1); PG8_SCHED; PG8_LDA(At, 1, 0); PG8_STAGE(PG8_SA(0, 1), a2 + hstep, voffA);
            PG8_WAIT_V(8); PG8_WAIT_L(0); PG8_BAR; PG8_MMA(0, 0, At, B0); PG8_MMA(0, 1, At, B1); PG8_BAR; PG8_SCHED;
            PG8_LDA(At, 1, 1); PG8_STAGE(PG8_SB(1, 0), b3, voffB); PG8_STAGE(PG8_SB(1, 1), b3 + hstep, voffB); PG8_STAGE(PG8_SA(1, 0), a3, voffA);
            PG8_WAIT_V(8); PG8_WAIT_L(0); PG8_BAR; PG8_MMA(1, 0, At, B0); PG8_MMA(1, 1, At, B1); PG8_BAR; PG8_SCHED;
            } else {
            PG8_LDB(B0, 0, 0); PG8_SCHED; PG8_LDA(At, 0, 0); PG8_STAGE(PG8_SA(1, 1), a1 + hstep, voffA);
            PG8_WAIT_L(8); PG8_BAR; PG8_WAIT_L(0); PG8_MMA(0, 0, At, B0); PG8_BAR; PG8_SCHED;
            PG8_LDB(B1, 0, 1); PG8_STAGE(PG8_SB(0, 0), b2, voffB);
            PG8_BAR; PG8_WAIT_L(0); PG8_MMA(0, 1, At, B1); PG8_BAR;
            PG8_LDA(At, 0, 1); PG8_STAGE(PG8_SA(0, 0), a2, voffA);
            PG8_BAR; PG8_WAIT_L(0); PG8_MMA(1, 0, At, B0); PG8_BAR; PG8_SCHED;
            PG8_STAGE(PG8_SB(0, 1), b2 + hstep, voffB);
            PG8_WAIT_V(6); PG8_BAR; PG8_MMA(1, 1, At, B1); PG8_BAR;
            PG8_LDB(B0, 1, 0); PG8_SCHED; PG8_LDA(At, 1, 0); PG8_STAGE(PG8_SA(0, 1), a2 + hstep, voffA);
            PG8_WAIT_L(8); PG8_BAR; PG8_WAIT_L(0); PG8_MMA(0, 0, At, B0); PG8_BAR; PG8_SCHED;
            PG8_LDB(B1, 1, 1); PG8_STAGE(PG8_SB(1, 0), b3, voffB);
            PG8_BAR; PG8_WAIT_L(0); PG8_MMA(0, 1, At, B1); PG8_BAR;
            PG8_LDA(At, 1, 1); PG8_STAGE(PG8_SA(1, 0), a3, voffA);
            PG8_BAR; PG8_WAIT_L(0); PG8_MMA(1, 0, At, B0); PG8_BAR; PG8_SCHED;
            PG8_STAGE(PG8_SB(1, 1), b3 + hstep, voffB);
            PG8_WAIT_V(6); PG8_BAR; PG8_MMA(1, 1, At, B1); PG8_BAR;
            }
        }
        if constexpr (ALIGN_EPI) { if (wr == 0) PG8_BAR; }
        if constexpr (!Epi::AFTER_DRAIN) { E(acc, cur, wr, wc, fr, fq); S.done(cur); }
        if (!has_next) break;
#pragma unroll
        for (int a = 0; a < 2; ++a)
#pragma unroll
            for (int b = 0; b < 2; ++b)
#pragma unroll
                for (int m = 0; m < 4; ++m)
#pragma unroll
                    for (int n = 0; n < 2; ++n) acc[a][b][m][n] = (f32x4){0.f, 0.f, 0.f, 0.f};
        cur = nxt; cA = nA; cB = nB; ++ui;
        if constexpr (ALIGN_EPI) { if (wr == 1) PG8_BAR; }
    }
    PG8_WAIT_V(0);
    if constexpr (!ALIGN_EPI) { if (wr == 0) PG8_BAR; }
    PG8_BAR;
    if constexpr (Epi::AFTER_DRAIN) { E.fused(acc, cur, wr, wc, fr, fq, lds, wid, lane); S.done(cur); }
#undef PG8_SA
#undef PG8_SB
#undef PG8_STAGE
#undef PG8_LDA
#undef PG8_LDB
#undef PG8_MMA
#undef PG8_WAIT_V
#undef PG8_WAIT_L
#undef PG8_BAR
#undef PG8_SCHED
}
}

using pg8::Unit;
struct Frame {
    unsigned char* lds; int tid, lane, wave, vcu, G;
    const float* in[29]; float* out; unsigned char* ws;
};
__device__ __forceinline__ int tile_which(int pm) { return pm < 64 ? (pm >> 5) : 2; }

constexpr int SG_LDT = 72;
template <class Epi>
__device__ __forceinline__ void sgemm_unit(unsigned char* lds, const bf16_t* A, int lda, const bf16_t* Bt, int ldb, int K, const Epi& E, const Unit u) {
    static_assert(!Epi::PERM, "sgemm_unit stages B rows in natural order");
    const int tid = threadIdx.x, wid = tid >> 6, lane = tid & 63, wr = wid >> 2, wc = wid & 3, fr = lane & 15, fq = lane >> 4;
    f32x4 acc[2][2][4][2];
#pragma unroll
    for (int a = 0; a < 2; ++a)
#pragma unroll
        for (int b = 0; b < 2; ++b)
#pragma unroll
            for (int m = 0; m < 4; ++m)
#pragma unroll
                for (int n = 0; n < 2; ++n) acc[a][b][m][n] = (f32x4){0.f, 0.f, 0.f, 0.f};
    bf16_t* As = (bf16_t*)lds; bf16_t* Bs = As + 256 * SG_LDT;
    for (int k0 = 0; k0 < K; k0 += 64) {
        bf16x8 ra[4], rb[4];
#pragma unroll
        for (int i = 0; i < 4; ++i) { const int p = tid + 512 * i, row = p >> 3, kc = (p & 7) * 8;
            ra[i] = *(const bf16x8*)(A + (size_t)row * lda + k0 + kc); rb[i] = *(const bf16x8*)(Bt + (size_t)row * ldb + k0 + kc); }
        __syncthreads();
#pragma unroll
        for (int i = 0; i < 4; ++i) { const int p = tid + 512 * i, row = p >> 3, kc = (p & 7) * 8;
            *(bf16x8*)(As + row * SG_LDT + kc) = ra[i]; *(bf16x8*)(Bs + row * SG_LDT + kc) = rb[i]; }
        __syncthreads();
#pragma unroll
        for (int kk = 0; kk < 2; ++kk) {
            bf16x8 bfr[2][2];
#pragma unroll
            for (int bj = 0; bj < 2; ++bj)
#pragma unroll
                for (int n = 0; n < 2; ++n) bfr[bj][n] = *(const bf16x8*)(Bs + (128 * bj + 32 * wc + 16 * n + fr) * SG_LDT + 32 * kk + 8 * fq);
#pragma unroll
            for (int ai = 0; ai < 2; ++ai) {
                bf16x8 af[4];
#pragma unroll
                for (int m = 0; m < 4; ++m) af[m] = *(const bf16x8*)(As + (128 * ai + 64 * wr + 16 * m + fr) * SG_LDT + 32 * kk + 8 * fq);
#pragma unroll
                for (int bj = 0; bj < 2; ++bj)
#pragma unroll
                    for (int m = 0; m < 4; ++m)
#pragma unroll
                        for (int n = 0; n < 2; ++n) acc[ai][bj][m][n] = __builtin_amdgcn_mfma_f32_16x16x32_bf16(bfr[bj][n], af[m], acc[ai][bj][m][n], 0, 0, 0);
            }
        }
    }
    __syncthreads();
    E(acc, u, wr, wc, fr, fq);
}

template <bool PERM> __device__ __forceinline__ int epi_col(int bj, int n, int wc, int fq) { return PERM ? (128 * bj + 32 * wc + 8 * fq + 4 * n) : (128 * bj + 32 * wc + 16 * n + 4 * fq); }
#define EPI_LOOP4 _Pragma("unroll") for (int ai = 0; ai < 2; ++ai) _Pragma("unroll") for (int m = 0; m < 4; ++m) _Pragma("unroll") for (int bj = 0; bj < 2; ++bj) _Pragma("unroll") for (int n = 0; n < 2; ++n)
__device__ __forceinline__ void st_bf16x4(bf16_t* p, f32x4 v) { u32x2 w; w.x = pk2(v[0], v[1]); w.y = pk2(v[2], v[3]); *(u32x2*)p = w; }
__device__ __forceinline__ void st_bf16x8(bf16_t* p, f32x4 v0, f32x4 v1) { u32x4 w; w.x = pg8::cvt_pk_bf16(v0[0], v0[1]); w.y = pg8::cvt_pk_bf16(v0[2], v0[3]); w.z = pg8::cvt_pk_bf16(v1[0], v1[1]); w.w = pg8::cvt_pk_bf16(v1[2], v1[3]); *(u32x4*)p = w; }
template <bool PERM> __device__ __forceinline__ void st_pair(bf16_t* rowp, int wc, int fq, int bj, f32x4 v0, f32x4 v1) {
    if (PERM) st_bf16x8(rowp + epi_col<true>(bj, 0, wc, fq), v0, v1);
    else { st_bf16x4(rowp + epi_col<false>(bj, 0, wc, fq), v0); st_bf16x4(rowp + epi_col<false>(bj, 1, wc, fq), v1); }
}

template <bool P> struct EpiStoreBf16 {
    static constexpr bool PERM = P, AFTER_DRAIN = false;
    bf16_t* O; int ldc; int pn_mod;
    __device__ __forceinline__ void operator()(const f32x4 (&acc)[2][2][4][2], const Unit& u, int wr, int wc, int fr, int fq) const {
        const int c0 = (u.pn % pn_mod) * 256;
#pragma unroll
        for (int ai = 0; ai < 2; ++ai)
#pragma unroll
            for (int m = 0; m < 4; ++m) { bf16_t* rowp = O + (size_t)(u.pm * 256 + 128 * ai + 64 * wr + 16 * m + fr) * ldc + c0;
#pragma unroll
                for (int bj = 0; bj < 2; ++bj) st_pair<P>(rowp, wc, fq, bj, acc[ai][bj][m][0], acc[ai][bj][m][1]); }
    }
};
template <bool P> struct EpiQKV {
    static constexpr bool PERM = P, AFTER_DRAIN = false;
    bf16_t *Q, *KB, *VB;
    __device__ __forceinline__ void operator()(const f32x4 (&acc)[2][2][4][2], const Unit& u, int wr, int wc, int fr, int fq) const {
        if (u.pn < 4 && u.pm >= 64) return;
#pragma unroll
        for (int ai = 0; ai < 2; ++ai)
#pragma unroll
            for (int m = 0; m < 4; ++m) { const int row = u.pm * 256 + 128 * ai + 64 * wr + 16 * m + fr; bf16_t* rowp;
                if (u.pn < 4) rowp = Q + (size_t)row * 1024 + u.pn * 256;
                else { int kvrow; if (row < TL) { const int b = row >> 13, t = row & 8191; kvrow = b * SKV + CL + t; } else { const int r2 = row - TL, b = r2 >> 8, t = r2 & 255; kvrow = b * SKV + t; }
                    rowp = ((u.pn == 4) ? KB : VB) + (size_t)kvrow * 256; }
#pragma unroll
                for (int bj = 0; bj < 2; ++bj) st_pair<P>(rowp, wc, fq, bj, acc[ai][bj][m][0], acc[ai][bj][m][1]); }
    }
};
struct EpiResid {
    static constexpr bool PERM = false, AFTER_DRAIN = false;
    const float* base_lat; float* out_lat; const float* base_ctx; float* out_ctx; const float* modl; int goff;
    __device__ __forceinline__ void operator()(const f32x4 (&acc)[2][2][4][2], const Unit& u, int wr, int wc, int fr, int fq) const {
        const float* g = modl + tile_which(u.pm) * 6144 + goff + u.pn * 256;
        const bool lat = u.pm < 64; const float* base = lat ? base_lat : base_ctx; float* out = lat ? out_lat : out_ctx; const int r0 = lat ? u.pm * 256 : (u.pm - 64) * 256;
        f32x4 gv[2][2];
#pragma unroll
        for (int bj = 0; bj < 2; ++bj)
#pragma unroll
            for (int n = 0; n < 2; ++n) gv[bj][n] = *(const f32x4*)(g + epi_col<false>(bj, n, wc, fq));
#pragma unroll
        for (int ai = 0; ai < 2; ++ai)
#pragma unroll
            for (int m = 0; m < 4; ++m) { const size_t ro = (size_t)(r0 + 128 * ai + 64 * wr + 16 * m + fr) * 1024 + u.pn * 256;
#pragma unroll
                for (int bj = 0; bj < 2; ++bj)
#pragma unroll
                    for (int n = 0; n < 2; ++n) { const int col = epi_col<false>(bj, n, wc, fq); const f32x4 bv = *(const f32x4*)(base + ro + col);
                        *(f32x4*)(out + ro + col) = bv + gv[bj][n] * acc[ai][bj][m][n]; }
                if (m & 1) asm volatile("" ::: "memory"); }
    }
};
template <bool P> struct EpiSwiglu {
    static constexpr bool PERM = P, AFTER_DRAIN = false;
    bf16_t* O; int ldc; int pn_mod;
    __device__ __forceinline__ void operator()(const f32x4 (&acc)[2][2][4][2], const Unit& u, int wr, int wc, int fr, int fq) const {
        const int c0 = (u.pn % pn_mod) * 128;
#pragma unroll
        for (int ai = 0; ai < 2; ++ai)
#pragma unroll
            for (int m = 0; m < 4; ++m) { bf16_t* rowp = O + (size_t)(u.pm * 256 + 128 * ai + 64 * wr + 16 * m + fr) * ldc + c0; f32x4 h[2];
#pragma unroll
                for (int n = 0; n < 2; ++n) { const f32x4 a = acc[ai][0][m][n], b = acc[ai][1][m][n];
#pragma unroll
                    for (int j = 0; j < 4; ++j) h[n][j] = siluf_(a[j]) * b[j]; }
                st_pair<P>(rowp, wc, fq, 0, h[0], h[1]); }
    }
};
struct EpiGates {
    static constexpr bool PERM = false, AFTER_DRAIN = false;
    const bf16_t* XC; bf16_t *LA, *BB; const float *b_a, *b_i, *c8; int blk;
    __device__ __forceinline__ void operator()(const f32x4 (&acc)[2][2][4][2], const Unit& u, int wr, int wc, int fr, int fq) const {
        const int d = u.pn;
#pragma unroll
        for (int n = 0; n < 2; ++n) { const int ch = blk * 128 + epi_col<PERM>(0, n, wc, fq);
            const f32x4 ba = *(const f32x4*)(b_a + d * 1024 + ch), bi = *(const f32x4*)(b_i + d * 1024 + ch), cc = *(const f32x4*)(c8 + d * 1024 + ch);
#pragma unroll
            for (int ai = 0; ai < 2; ++ai)
#pragma unroll
                for (int m = 0; m < 4; ++m) { const int row = u.pm * 256 + 128 * ai + 64 * wr + 16 * m + fr;
                    const u32x2 xw = *(const u32x2*)(XC + (size_t)row * 1024 + ch); const float xc[4] = {bflo(xw.x), bfhi(xw.x), bflo(xw.y), bfhi(xw.y)};
                    f32x4 la, bb;
#pragma unroll
                    for (int j = 0; j < 4; ++j) { const float r = sigmoidf_(acc[ai][0][m][n][j] + ba[j]), ig = sigmoidf_(acc[ai][1][m][n][j] + bi[j]);
                        const float l = cc[j] * r; la[j] = l; bb[j] = sqrtf(-expm1f(2.0f * l)) * (ig * xc[j]); }
                    const size_t o = ((size_t)d * TA + row) * 1024 + ch; st_bf16x4(LA + o, la); st_bf16x4(BB + o, bb); } }
    }
};
struct MoeOrder {
    pg8::StaticOrder so; const int* tile_e; int NT;
    __device__ __forceinline__ void init(int nMt, int NT_, int G, int c, const int* te) { so.init(nMt * 256, NT_ * 256, G, c); tile_e = te; NT = NT_; }
    __device__ __forceinline__ bool next(int i, Unit& u) const { if (!so.next(i, u)) return false; u.pn += tile_e[u.pm] * NT; return true; }
    __device__ __forceinline__ void a_ready(const Unit&) const {}
    __device__ __forceinline__ void done(const Unit&) const {}
};

__device__ __forceinline__ void p0_item(const float* W, int ldw, int k0, int n0, bf16_t* dst_row0, int ldd, LAS float* scr, int lane) {
#pragma unroll 8
    for (int i = 0; i < 32; ++i) { const int kk = 2 * i + (lane >> 5); scr[kk * 33 + (lane & 31)] = W[(size_t)(k0 + kk) * ldw + n0 + (lane & 31)]; }
    asm volatile("s_waitcnt lgkmcnt(0)" ::: "memory");
    const int c = lane & 7;
#pragma unroll
    for (int j = 0; j < 4; ++j) { const int n = (lane >> 3) + 8 * j; const LAS float* s = scr + (8 * c) * 33 + n;
        u32x4 o; o.x = pk2(s[0 * 33], s[1 * 33]); o.y = pk2(s[2 * 33], s[3 * 33]); o.z = pk2(s[4 * 33], s[5 * 33]); o.w = pk2(s[6 * 33], s[7 * 33]);
        *(u32x4*)(dst_row0 + (size_t)n * ldd + k0 + 8 * c) = o; }
    asm volatile("s_waitcnt lgkmcnt(0)" ::: "memory");
}
__device__ __forceinline__ int il_row(int n, int up) { return (n >> 7) * 256 + up * 128 + (n & 127); }

__device__ __forceinline__ void p0_prologue(Frame& F) {
    unsigned char* ws = F.ws;
    if (F.vcu < 192) {
        float* sv = (float*)F.lds;
        float* red = sv + 3 * 1024;
        for (int i = F.tid; i < 3 * 1024; i += NTHR) { const int w = i >> 10, k = i & 1023; const float v = (w < 2) ? F.in[1][w * 1024 + k] : F.in[3][k]; sv[i] = siluf_(v); }
        __syncthreads();
        const int layer = F.vcu / 96, n0 = (F.vcu % 96) * 64;
        const float* W = F.in[4] + (size_t)layer * 1024 * 6144 + n0 + F.lane;
        float a0 = 0.f, a1 = 0.f, a2 = 0.f;
#pragma unroll 8
        for (int k = F.wave * 128; k < F.wave * 128 + 128; ++k) { const float w = W[(size_t)k * 6144]; a0 += sv[k] * w; a1 += sv[1024 + k] * w; a2 += sv[2048 + k] * w; }
        red[(F.wave * 3 + 0) * 64 + F.lane] = a0; red[(F.wave * 3 + 1) * 64 + F.lane] = a1; red[(F.wave * 3 + 2) * 64 + F.lane] = a2;
        __syncthreads();
        if (F.tid < 192) { const int w = F.tid >> 6, l = F.tid & 63; float s = 0.f;
#pragma unroll
            for (int q = 0; q < 8; ++q) s += red[(q * 3 + w) * 64 + l];
            ((float*)(ws + WS_MOD))[(size_t)(layer * 3 + w) * 6144 + n0 + l] = s + F.in[5][layer * 6144 + n0 + l]; }
        __syncthreads();
    }
    if (F.vcu == 255) for (int i = F.tid; i < 2048; i += NTHR) { const float lam = F.in[15][i]; const float sp = (-lam > 20.f) ? -lam : log1pf(__expf(-lam)); ((float*)(ws + WS_C8))[i] = -8.0f * sp; }
    LAS float* scr = (LAS float*)(F.lds) + F.wave * 4096;
    const int gw = F.vcu * NWAVES + F.wave, NGW = F.G * NWAVES;
    constexpr int I_IN = 16 * 64, I_G = 32 * 8, I_OUT = 16 * 32, I_QKV = 16 * 48, I_O = 16 * 32, I_F1 = 16 * 88, I_F2 = 44 * 32, I_M1 = 16 * 112, I_M2 = 56 * 32;
    constexpr int NITEMS = I_IN + I_G + I_OUT + I_QKV + I_O + 2 * I_F1 + I_F2 + 16 * I_M1 + 8 * I_M2;
    for (int it = gw; it < NITEMS; it += NGW) {
        int r = it;
        if (r < I_IN) { const int kb = r / 64, nb = r % 64; p0_item(F.in[8], 2048, kb * 64, nb * 32, (bf16_t*)(ws + WS_W_IN) + (size_t)(nb * 32) * 1024, 1024, scr, F.lane); continue; } r -= I_IN;
        if (r < I_G) { const int mat = r >> 3, kb = (r >> 2) & 1, nb = r & 3; const int d = mat >> 4, gate = (mat >> 3) & 1, blk = mat & 7;
            const float* src = (gate ? F.in[13] : F.in[11]) + (size_t)(d * 8 + blk) * 128 * 128;
            p0_item(src, 128, kb * 64, nb * 32, (bf16_t*)(ws + WS_W_GATE) + (size_t)(blk * 512 + (d * 2 + gate) * 128 + nb * 32) * 128, 128, scr, F.lane); continue; } r -= I_G;
        if (r < I_OUT) { const int kb = r / 32, nb = r % 32; p0_item(F.in[16], 1024, kb * 64, nb * 32, (bf16_t*)(ws + WS_W_OUT) + (size_t)(nb * 32) * 1024, 1024, scr, F.lane); continue; } r -= I_OUT;
        if (r < I_QKV) { const int kb = r / 48, nb = r % 48; p0_item(F.in[17], 1536, kb * 64, nb * 32, (bf16_t*)(ws + WS_W_QKV) + (size_t)(nb * 32) * 1024, 1024, scr, F.lane); continue; } r -= I_QKV;
        if (r < I_O) { const int kb = r / 32, nb = r % 32; p0_item(F.in[20], 1024, kb * 64, nb * 32, (bf16_t*)(ws + WS_W_O) + (size_t)(nb * 32) * 1024, 1024, scr, F.lane); continue; } r -= I_O;
        if (r < 2 * I_F1) { const int up = r / I_F1, q = r % I_F1, kb = q / 88, nb = q % 88;
            p0_item(up ? F.in[22] : F.in[21], DFF, kb * 64, nb * 32, (bf16_t*)(ws + WS_W13) + (size_t)il_row(nb * 32, up) * 1024, 1024, scr, F.lane); continue; } r -= 2 * I_F1;
        if (r < I_F2) { const int kb = r / 32, nb = r % 32; p0_item(F.in[23], 1024, kb * 64, nb * 32, (bf16_t*)(ws + WS_W2) + (size_t)(nb * 32) * DFF, DFF, scr, F.lane); continue; } r -= I_F2;
        if (r < 16 * I_M1) { const int up = r / (8 * I_M1), q = r % (8 * I_M1), e = q / I_M1, q2 = q % I_M1, kb = q2 / 112, nb = q2 % 112;
            p0_item((up ? F.in[26] : F.in[25]) + (size_t)e * 1024 * DFE, DFE, kb * 64, nb * 32, (bf16_t*)(ws + WS_MW13) + ((size_t)e * 2 * DFE + il_row(nb * 32, up)) * 1024, 1024, scr, F.lane); continue; } r -= 16 * I_M1;
        { const int e = r / I_M2, q2 = r % I_M2, kb = q2 / 32, nb = q2 % 32;
            p0_item(F.in[27] + (size_t)e * DFE * 1024, 1024, kb * 64, nb * 32, (bf16_t*)(ws + WS_MW2) + ((size_t)e * 1024 + nb * 32) * DFE, DFE, scr, F.lane); }
    }
}

template <bool ROUTER>
__device__ __forceinline__ void modnorm_phase(Frame& F, const float* src_lat, const float* src_ctx, int nrows, const float* normg, const float* modl, int sh_idx, int sc_idx, bf16_t* H) {
    LAS float* RT = (LAS float*)F.lds;
    LAS int* lcnt = (LAS int*)(F.lds + 32768);
    LAS int* lrow = (LAS int*)(F.lds + 32768 + 64);
    if (ROUTER) {
        for (int i = F.tid; i < 8192; i += NTHR) RT[i] = F.in[24][i];
        if (F.tid < 16) lcnt[F.tid] = 0;
        __syncthreads();
    }
    int nloc = 0;
    for (int row = F.vcu * NWAVES + F.wave; row < nrows; row += F.G * NWAVES, ++nloc) {
        const bool lat = row < TL; const float* xr = lat ? src_lat + (size_t)row * 1024 : src_ctx + (size_t)(row - TL) * 1024;
        const int which = lat ? (row >> 13) : 2; const float* sh = modl + which * 6144 + sh_idx * 1024; const float* sc = modl + which * 6144 + sc_idx * 1024;
        f32x4 v[4]; float ss = 0.f;
#pragma unroll
        for (int j = 0; j < 4; ++j) { v[j] = *(const f32x4*)(xr + 4 * F.lane + 256 * j); ss += (v[j][0] * v[j][0] + v[j][1] * v[j][1]) + (v[j][2] * v[j][2] + v[j][3] * v[j][3]); }
        const float rstd = 1.0f / sqrtf(wave_sum(ss) * (1.0f / 1024.0f) + EPS);
#pragma unroll
        for (int j = 0; j < 4; ++j) { const int c = 4 * F.lane + 256 * j; const f32x4 g = *(const f32x4*)(normg + c), s1 = *(const f32x4*)(sc + c), s0 = *(const f32x4*)(sh + c);
            v[j] = (v[j] * rstd * g) * (1.0f + s1) + s0;
            st_bf16x4(H + (size_t)row * 1024 + c, v[j]); }
        if (ROUTER) {
            float lg[8];
#pragma unroll
            for (int e = 0; e < 8; ++e) lg[e] = 0.f;
#pragma unroll
            for (int j = 0; j < 4; ++j)
#pragma unroll
                for (int i = 0; i < 4; ++i) { const int k = 4 * F.lane + 256 * j + i; const f32x4 r0 = *(const LAS f32x4*)(RT + k * 8), r1 = *(const LAS f32x4*)(RT + k * 8 + 4); const float h = v[j][i];
                    lg[0] += h * r0[0]; lg[1] += h * r0[1]; lg[2] += h * r0[2]; lg[3] += h * r0[3]; lg[4] += h * r1[0]; lg[5] += h * r1[1]; lg[6] += h * r1[2]; lg[7] += h * r1[3]; }
#pragma unroll
            for (int e = 0; e < 8; ++e) lg[e] = wave_sum(lg[e]);
            int e0 = 0; float l0 = lg[0];
#pragma unroll
            for (int e = 1; e < 8; ++e) if (lg[e] > l0) { l0 = lg[e]; e0 = e; }
            int e1 = -1; float l1 = -3.0e38f;
#pragma unroll
            for (int e = 0; e < 8; ++e) if (e != e0 && lg[e] > l1) { l1 = lg[e]; e1 = e; }
            const float p1 = __expf(l1 - l0), w0 = 1.0f / (1.0f + p1), w1 = p1 / (1.0f + p1);
            if (F.lane == 0) {
                ((float*)(F.ws + WS_TOKW))[row * 2 + 0] = w0; ((float*)(F.ws + WS_TOKW))[row * 2 + 1] = w1;
                const int r0 = atomicAdd((int*)&((int*)lcnt)[e0], 1), r1 = atomicAdd((int*)&((int*)lcnt)[e1], 1);
                const int li = nloc * NWAVES + F.wave; lrow[li * 5 + 0] = row; lrow[li * 5 + 1] = e0; lrow[li * 5 + 2] = e1; lrow[li * 5 + 3] = r0; lrow[li * 5 + 4] = r1;
            }
        }
    }
    if (ROUTER) {
        __syncthreads();
        if (F.tid < 8) lcnt[8 + F.tid] = (int)__hip_atomic_fetch_add((unsigned*)(F.ws + WS_CTL) + CW_GCNT + F.tid, (unsigned)lcnt[F.tid], RLX_AGENT);
        __syncthreads();
        for (int li = F.tid; li < 128; li += NTHR) { const int i = li / NWAVES, w = li % NWAVES; const int row = F.vcu * NWAVES + w + i * F.G * NWAVES;
            if (row < nrows) { const int e0 = lrow[li * 5 + 1], e1 = lrow[li * 5 + 2];
                ((int*)(F.ws + WS_TOKE))[row] = e0 | (e1 << 8);
                ((int*)(F.ws + WS_RANK))[row * 2 + 0] = lcnt[8 + e0] + lrow[li * 5 + 3]; ((int*)(F.ws + WS_RANK))[row * 2 + 1] = lcnt[8 + e1] + lrow[li * 5 + 4]; } }
        __syncthreads();
    }
}

__device__ __forceinline__ void conv_phase(Frame& F) {
    const bf16_t* XG = (const bf16_t*)(F.ws + WS_XG); bf16_t* XC = (bf16_t*)(F.ws + WS_XC);
    const float* cw = F.in[9]; const float* cb = F.in[10];
    const int total = TA * 128;
    for (int it = F.vcu * NTHR + F.tid; it < total; it += F.G * NTHR) {
        const int row = it >> 7, c0 = (it & 127) * 8;
        int t, len; if (row < TL) { t = row & 8191; len = SEQ; } else { t = (row - TL) & 255; len = CL; }
        float a[8];
#pragma unroll
        for (int j = 0; j < 8; ++j) a[j] = cb[c0 + j];
#pragma unroll
        for (int k = 0; k < 4; ++k) { const int tt = t + k - 2;
            if (tt >= 0 && tt < len) { const u32x4 xw = *(const u32x4*)(XG + (size_t)(row + k - 2) * 2048 + c0); const f32x4 w0 = *(const f32x4*)(cw + k * 1024 + c0), w1 = *(const f32x4*)(cw + k * 1024 + c0 + 4);
                a[0] += bflo(xw.x) * w0[0]; a[1] += bfhi(xw.x) * w0[1]; a[2] += bflo(xw.y) * w0[2]; a[3] += bfhi(xw.y) * w0[3];
                a[4] += bflo(xw.z) * w1[0]; a[5] += bfhi(xw.z) * w1[1]; a[6] += bflo(xw.w) * w1[2]; a[7] += bfhi(xw.w) * w1[3]; } }
        u32x4 o; o.x = pk2(a[0], a[1]); o.y = pk2(a[2], a[3]); o.z = pk2(a[4], a[5]); o.w = pk2(a[6], a[7]);
        *(u32x4*)(XC + (size_t)row * 1024 + c0) = o;
    }
}
__device__ __forceinline__ void scan_agg_phase(Frame& F) {
    const bf16_t* LA = (const bf16_t*)(F.ws + WS_LA); const bf16_t* BB = (const bf16_t*)(F.ws + WS_BB);
    float* AP = (float*)(F.ws + WS_AGGP); float* AQ = (float*)(F.ws + WS_AGGQ);
    const int total = 2 * NCHUNK * 512;
    for (int it = F.vcu * NTHR + F.tid; it < total; it += F.G * NTHR) {
        const int cp = it & 511, ck = (it >> 9) % NCHUNK, d = it / (512 * NCHUNK);
        const size_t base = ((size_t)d * TA + (size_t)ck * SCH) * 1024 + cp * 2;
        float p0 = 1.f, p1 = 1.f, q0 = 0.f, q1 = 0.f;
#pragma unroll 8
        for (int s = 0; s < SCH; ++s) { const int t = d ? (SCH - 1 - s) : s; const unsigned lw = *(const unsigned*)(LA + base + (size_t)t * 1024), bw = *(const unsigned*)(BB + base + (size_t)t * 1024);
            const float a0 = __expf(bflo(lw)), a1 = __expf(bfhi(lw)); p0 *= a0; p1 *= a1; q0 = a0 * q0 + bflo(bw); q1 = a1 * q1 + bfhi(bw); }
        const size_t o = ((size_t)d * NCHUNK + ck) * 1024 + cp * 2;
        *(f32x2*)(AP + o) = (f32x2){p0, p1}; *(f32x2*)(AQ + o) = (f32x2){q0, q1};
    }
}
__device__ __forceinline__ void scan_carry_phase(Frame& F) {
    const float* AP = (const float*)(F.ws + WS_AGGP); const float* AQ = (const float*)(F.ws + WS_AGGQ); float* CR = (float*)(F.ws + WS_CARRY);
    const int it = F.vcu * NTHR + F.tid;
    if (it < 2 * NB * 1024) {
        const int ch = it & 1023, b = (it >> 10) & 1, d = it >> 11;
        float h = 0.f;
        const int cbase = TL / SCH + b * (CL / SCH), lbase = b * (SEQ / SCH);
#pragma unroll 8
        for (int j = 0; j < CL / SCH; ++j) { const int ck = cbase + (d ? (CL / SCH - 1 - j) : j); const size_t o = ((size_t)d * NCHUNK + ck) * 1024 + ch; CR[o] = h; h = AP[o] * h + AQ[o]; }
#pragma unroll 8
        for (int j = 0; j < SEQ / SCH; ++j) { const int ck = lbase + (d ? (SEQ / SCH - 1 - j) : j); const size_t o = ((size_t)d * NCHUNK + ck) * 1024 + ch; CR[o] = h; h = AP[o] * h + AQ[o]; }
    }
}
__device__ __forceinline__ void scan_apply_phase(Frame& F) {
    const bf16_t* LA = (const bf16_t*)(F.ws + WS_LA); const bf16_t* BB = (const bf16_t*)(F.ws + WS_BB); const float* CR = (const float*)(F.ws + WS_CARRY);
    const bf16_t* XG = (const bf16_t*)(F.ws + WS_XG); bf16_t* YG = (bf16_t*)(F.ws + WS_YG);
    const int total = NCHUNK * 512;
    for (int it = F.vcu * NTHR + F.tid; it < total; it += F.G * NTHR) {
        const int cp = it & 511, ck = it >> 9;
        float y0[SCH], y1[SCH];
        { const size_t base = ((size_t)ck * SCH) * 1024 + cp * 2; const f32x2 c = *(const f32x2*)(CR + (size_t)ck * 1024 + cp * 2); float h0 = c.x, h1 = c.y;
#pragma unroll
            for (int t = 0; t < SCH; ++t) { const unsigned lw = *(const unsigned*)(LA + base + (size_t)t * 1024), bw = *(const unsigned*)(BB + base + (size_t)t * 1024);
                h0 = __expf(bflo(lw)) * h0 + bflo(bw); h1 = __expf(bfhi(lw)) * h1 + bfhi(bw); y0[t] = h0; y1[t] = h1; } }
        { const size_t base = ((size_t)TA + (size_t)ck * SCH) * 1024 + cp * 2; const f32x2 c = *(const f32x2*)(CR + ((size_t)NCHUNK + ck) * 1024 + cp * 2); float h0 = c.x, h1 = c.y;
#pragma unroll
            for (int s = 0; s < SCH; ++s) { const int t = SCH - 1 - s; const unsigned lw = *(const unsigned*)(LA + base + (size_t)t * 1024), bw = *(const unsigned*)(BB + base + (size_t)t * 1024);
                h0 = __expf(bflo(lw)) * h0 + bflo(bw); h1 = __expf(bfhi(lw)) * h1 + bfhi(bw); y0[t] += h0; y1[t] += h1; } }
#pragma unroll
        for (int t = 0; t < SCH; ++t) { const size_t row = (size_t)ck * SCH + t; const unsigned gw = *(const unsigned*)(XG + row * 2048 + 1024 + cp * 2);
            *(unsigned*)(YG + row * 1024 + cp * 2) = pk2(y0[t] * gelu_tanh(bflo(gw)), y1[t] * gelu_tanh(bfhi(gw))); }
    }
}

__device__ __forceinline__ void qknorm_head(bf16_t* p, const float* g, bool rope, float cs, float sn, int lane) {
    const int i1 = lane + ((lane >= 32) ? 32 : 0), i2 = i1 + 32;
    const float x1 = bf2f(p[i1]), x2 = bf2f(p[i2]);
    const float rstd = 1.0f / sqrtf(wave_sum(x1 * x1 + x2 * x2) * (1.0f / 128.0f) + EPS);
    const float y1 = x1 * rstd * g[i1], y2 = x2 * rstd * g[i2];
    float o1 = y1, o2 = y2; if (rope) { o1 = y1 * cs - y2 * sn; o2 = y2 * cs + y1 * sn; }
    p[i1] = (bf16_t)f2bf(o1); p[i2] = (bf16_t)f2bf(o2);
}
__device__ __forceinline__ void qkrope_phase(Frame& F) {
    bf16_t* Q = (bf16_t*)(F.ws + WS_Q); bf16_t* KB = (bf16_t*)(F.ws + WS_KB);
    const float* qg = F.in[18]; const float* kg = F.in[19];
    const int j = F.lane & 31; const float freq = powf(10000.0f, -(float)j / 32.0f);
    for (int row = F.vcu * NWAVES + F.wave; row < TA; row += F.G * NWAVES) {
        if (row < TL) { const int b = row >> 13, t = row & 8191; const float pos = (F.lane < 32) ? (float)(t >> 6) : (float)(t & 63); float sn, cs; sincosf(pos * freq, &sn, &cs);
#pragma unroll 1
            for (int h = 0; h < 8; ++h) qknorm_head(Q + (size_t)row * 1024 + h * 128, qg, true, cs, sn, F.lane);
#pragma unroll 1
            for (int h = 0; h < 2; ++h) qknorm_head(KB + ((size_t)b * SKV + CL + t) * 256 + h * 128, kg, true, cs, sn, F.lane);
        } else { const int r2 = row - TL, b = r2 >> 8, t = r2 & 255;
#pragma unroll 1
            for (int h = 0; h < 2; ++h) qknorm_head(KB + ((size_t)b * SKV + t) * 256 + h * 128, kg, false, 1.f, 0.f, F.lane); }
    }
}

namespace attn {
constexpr int QBLK = 32, KVBLK = 64, LDQ = 1024, LDK = 256, LDO = 1024;
constexpr float SCALE = 0.088388347648318440f;
constexpr float THR = 8.f;
constexpr size_t SHM_V = KVBLK * HD * 2, SHM_K = KVBLK * HD * 2, SHM_ATTN = 2 * SHM_V + 2 * SHM_K + 8 * 64 * 4;
using s16x4 = __attribute__((ext_vector_type(4))) short;
#define KSWZ(row, colB) ((row) * 256 + ((colB) ^ (((row) & 7) << 4)))
#define SBAR() __builtin_amdgcn_sched_barrier(0)
__device__ __forceinline__ int crow(int r, int hi) { return (r & 3) + 8 * (r >> 2) + 4 * hi; }
__device__ __forceinline__ unsigned cvtpk(float lo, float hi) { unsigned r; asm volatile("v_cvt_pk_bf16_f32 %0, %1, %2" : "=v"(r) : "v"(lo), "v"(hi)); return r; }
__device__ __forceinline__ void partialSM(f32x16& p0, f32x16& p1, float& m_reg, float& mn, float& alpha) {
  constexpr float C = SCALE * 1.4426950408889634f;
  float pmax = p0[0]; for (int r = 1; r < 16; ++r) pmax = fmaxf(pmax, p0[r]); for (int r = 0; r < 16; ++r) pmax = fmaxf(pmax, p1[r]);
  { auto rr = __builtin_amdgcn_permlane32_swap(__float_as_uint(pmax), __float_as_uint(pmax), false, false);
    pmax = fmaxf(__uint_as_float(rr[0]), __uint_as_float(rr[1])); }
  if (__builtin_expect(__all(pmax - m_reg <= THR / SCALE), 1)) { mn = m_reg; alpha = 1.f; }
  else { mn = fmaxf(m_reg, pmax); alpha = __builtin_amdgcn_exp2f((m_reg - mn) * C); m_reg = mn; }
  float mnC = -mn * C;
  for (int r = 0; r < 16; ++r) p0[r] = fmaf(p0[r], C, mnC); for (int r = 0; r < 16; ++r) p1[r] = fmaf(p1[r], C, mnC);
  for (int r = 0; r < 16; ++r) p0[r] = __builtin_amdgcn_exp2f(p0[r]);
}
__device__ __forceinline__ void finishSM(f32x16& p0, f32x16& p1, float alpha, float& l_reg, bf16x8& pa0, bf16x8& pa1, bf16x8& pa2, bf16x8& pa3) {
  for (int r = 0; r < 16; ++r) p1[r] = __builtin_amdgcn_exp2f(p1[r]);
  float ps = 0; for (int r = 0; r < 16; ++r) ps += p0[r]; for (int r = 0; r < 16; ++r) ps += p1[r];
  { auto rr = __builtin_amdgcn_permlane32_swap(__float_as_uint(ps), __float_as_uint(ps), false, false);
    ps = __uint_as_float(rr[0]) + __uint_as_float(rr[1]); }
  l_reg = l_reg * alpha + ps;
#define PK4(P, BASE, OUT) do { unsigned a0 = cvtpk(P[BASE + 0], P[BASE + 1]), a1 = cvtpk(P[BASE + 2], P[BASE + 3]);   \
    unsigned b0 = cvtpk(P[BASE + 4], P[BASE + 5]), b1 = cvtpk(P[BASE + 6], P[BASE + 7]);                              \
    auto r0 = __builtin_amdgcn_permlane32_swap(a0, b0, false, false); auto r1 = __builtin_amdgcn_permlane32_swap(a1, b1, false, false); \
    u32x4 w = {r0[0], r1[0], r0[1], r1[1]}; OUT = *reinterpret_cast<bf16x8*>(&w); } while (0)
  PK4(p0, 0, pa0); PK4(p0, 8, pa1); PK4(p1, 0, pa2); PK4(p1, 8, pa3);
#undef PK4
}
__device__ __forceinline__ void qkt(f32x16& p0, f32x16& p1, const bf16_t* Ks, const bf16x8* qr, int r32, int hi) {
  p0 = f32x16{}; p1 = f32x16{};
  for (int d0 = 0; d0 < 8; ++d0) { int cb = (d0 * 16 + hi * 8) * 2;
    bf16x8 b0 = *reinterpret_cast<const bf16x8*>((const char*)Ks + KSWZ(r32, cb));
    bf16x8 b1 = *reinterpret_cast<const bf16x8*>((const char*)Ks + KSWZ(32 + r32, cb));
    p0 = __builtin_amdgcn_mfma_f32_32x32x16_bf16(b0, qr[d0], p0, 0, 0, 0);
    p1 = __builtin_amdgcn_mfma_f32_32x32x16_bf16(b1, qr[d0], p1, 0, 0, 0); }
}
__device__ __forceinline__ int v_st(int k, int c) { const int kk = (k & ~0xC) | ((k & 4) << 1) | ((k & 8) >> 1); return ((kk >> 3) * 4 + (c >> 5)) * 512 + ((kk & 7) * 32 + (c & 31)) * 2; }
__device__ __forceinline__ int v_rd_base(int lane) { return ((lane & 3) << 3) | (((lane >> 2) & 3) << 6) | (((lane >> 4) & 1) << 5) | (((lane >> 5) & 1) << 8); }
constexpr int v_rd_off(int d0, int ks, int half) { return d0 * 512 + ks * 4096 + half * 2048; }
template <int OFF> __device__ __forceinline__ s16x4 tr_read(int vb) {
  s16x4 r; asm volatile("ds_read_b64_tr_b16 %0, %1 offset:%2" : "=&v"(r) : "v"(vb), "i"(OFF) : "memory"); return r;
}
template <int D0> __device__ __forceinline__ void pv_one(f32x16& od, int vb, bf16x8 pa0, bf16x8 pa1, bf16x8 pa2, bf16x8 pa3) {
  const s16x4 l0 = tr_read<v_rd_off(D0, 0, 0)>(vb), h0 = tr_read<v_rd_off(D0, 0, 1)>(vb), l1 = tr_read<v_rd_off(D0, 1, 0)>(vb), h1 = tr_read<v_rd_off(D0, 1, 1)>(vb);
  const s16x4 l2 = tr_read<v_rd_off(D0, 2, 0)>(vb), h2 = tr_read<v_rd_off(D0, 2, 1)>(vb), l3 = tr_read<v_rd_off(D0, 3, 0)>(vb), h3 = tr_read<v_rd_off(D0, 3, 1)>(vb);
  asm volatile("s_waitcnt lgkmcnt(0)" ::: "memory"); SBAR();
#define PK(L, H) (bf16x8){L[0], L[1], L[2], L[3], H[0], H[1], H[2], H[3]}
  od = __builtin_amdgcn_mfma_f32_32x32x16_bf16(pa0, PK(l0, h0), od, 0, 0, 0);
  od = __builtin_amdgcn_mfma_f32_32x32x16_bf16(pa1, PK(l1, h1), od, 0, 0, 0);
  od = __builtin_amdgcn_mfma_f32_32x32x16_bf16(pa2, PK(l2, h2), od, 0, 0, 0);
  od = __builtin_amdgcn_mfma_f32_32x32x16_bf16(pa3, PK(l3, h3), od, 0, 0, 0);
#undef PK
}
__device__ __forceinline__ void pv_d0(f32x16* o, int vb, bf16x8 pa0, bf16x8 pa1, bf16x8 pa2, bf16x8 pa3) {
  pv_one<0>(o[0], vb, pa0, pa1, pa2, pa3); pv_one<1>(o[1], vb, pa0, pa1, pa2, pa3); pv_one<2>(o[2], vb, pa0, pa1, pa2, pa3); pv_one<3>(o[3], vb, pa0, pa1, pa2, pa3);
}
__device__ __forceinline__ void attn_dense_body(const bf16_t* __restrict__ Qb, const bf16_t* __restrict__ Kh, const bf16_t* __restrict__ Vh, bf16_t* __restrict__ Ob, int seq, char* lds) {
  const int tid = threadIdx.x, wid = tid >> 6, lane = tid & 63, r32 = lane & 31, hi = lane >> 5;
  bf16_t* V_lds = (bf16_t*)lds; bf16_t* K_lds = (bf16_t*)(lds + 2 * SHM_V);
  float* ws = (float*)(lds + 2 * SHM_V + 2 * SHM_K) + wid * 64; float* li_l = ws; float* al_l = ws + 32;
  float m_reg = -1e30f, l_reg = 0; f32x16 o[4] = {}; bf16x8 qr[8];
  const bf16_t* Qw = Qb + (long)(wid * QBLK + r32) * LDQ + hi * 8;
#pragma unroll
  for (int d0 = 0; d0 < 8; ++d0) qr[d0] = *reinterpret_cast<const bf16x8*>(Qw + d0 * 16);
  const int sr = tid >> 4, sc = (tid & 15) * 8, vst0 = v_st(sr, sc), vst1 = v_st(32 + sr, sc);
  const int vb0 = (int)(uintptr_t)V_lds + v_rd_base(lane);
  struct { bf16x8 vs0, vs1, ks0, ks1; } sr_[2];
#define SLOAD(i, k0) do { sr_[i].vs0 = *reinterpret_cast<const bf16x8*>(&Vh[(long)((k0) + sr) * LDK + sc]); sr_[i].vs1 = *reinterpret_cast<const bf16x8*>(&Vh[(long)((k0) + 32 + sr) * LDK + sc]); \
    sr_[i].ks0 = *reinterpret_cast<const bf16x8*>(&Kh[(long)((k0) + sr) * LDK + sc]); sr_[i].ks1 = *reinterpret_cast<const bf16x8*>(&Kh[(long)((k0) + 32 + sr) * LDK + sc]); } while (0)
#define SWRITE(b, i) do { *(bf16x8*)((char*)V_lds + (b) * SHM_V + vst0) = sr_[i].vs0;          \
    *(bf16x8*)((char*)V_lds + (b) * SHM_V + vst1) = sr_[i].vs1; int kc = sc * 2;               \
    *(bf16x8*)((char*)K_lds + (b) * SHM_K + KSWZ(sr, kc)) = sr_[i].ks0;                       \
    *(bf16x8*)((char*)K_lds + (b) * SHM_K + KSWZ(32 + sr, kc)) = sr_[i].ks1; } while (0)
#define SWAIT() asm volatile("s_waitcnt vmcnt(4)" ::: "memory")
#define RESC(a) do { if (__any((a) < 1.f)) { if (hi == 0) al_l[r32] = (a); asm volatile("s_waitcnt lgkmcnt(0)" ::: "memory"); \
    for (int d = 0; d < 4; ++d) for (int r = 0; r < 16; ++r) o[d][r] *= al_l[crow(r, hi)]; } } while (0)
  f32x16 pA0, pA1, pB0, pB1; float mnA, mnB, alA, alB; bf16x8 pa0, pa1, pa2, pa3; const int NT = seq / KVBLK;
  constexpr int SE = 0, SO = 1;
  SLOAD(SE, 0); asm volatile("s_waitcnt vmcnt(0)" ::: "memory"); SWRITE(0, SE); __syncthreads();
  qkt(pA0, pA1, K_lds, qr, r32, hi); partialSM(pA0, pA1, m_reg, mnA, alA);
  SLOAD(SO, KVBLK); if (2 < NT) SLOAD(SE, 2 * KVBLK);
  SWAIT(); SWRITE(1, SO); __syncthreads();
  for (int j = 1; j + 1 < NT; j += 2) {
    SBAR(); qkt(pB0, pB1, (bf16_t*)((char*)K_lds + SHM_K), qr, r32, hi);
    finishSM(pA0, pA1, alA, l_reg, pa0, pa1, pa2, pa3); SBAR();
    SLOAD(SO, (j + 2) * KVBLK); SBAR();
    pv_d0(o, vb0, pa0, pa1, pa2, pa3); partialSM(pB0, pB1, m_reg, mnB, alB);
    __syncthreads(); SWAIT(); SWRITE(0, SE);
    RESC(alB); __syncthreads();
    SBAR(); qkt(pA0, pA1, K_lds, qr, r32, hi);
    finishSM(pB0, pB1, alB, l_reg, pa0, pa1, pa2, pa3); SBAR();
    if (j + 3 < NT) SLOAD(SE, (j + 3) * KVBLK); SBAR();
    pv_d0(o, vb0 + (int)SHM_V, pa0, pa1, pa2, pa3); partialSM(pA0, pA1, m_reg, mnA, alA);
    __syncthreads(); SWAIT(); SWRITE(1, SO);
    RESC(alA); __syncthreads();
  }
  SBAR(); qkt(pB0, pB1, (bf16_t*)((char*)K_lds + SHM_K), qr, r32, hi);
  finishSM(pA0, pA1, alA, l_reg, pa0, pa1, pa2, pa3); SBAR();
  pv_d0(o, vb0, pa0, pa1, pa2, pa3); partialSM(pB0, pB1, m_reg, mnB, alB);
  __syncthreads(); RESC(alB);
  finishSM(pB0, pB1, alB, l_reg, pa0, pa1, pa2, pa3); SBAR();
  pv_d0(o, vb0 + (int)SHM_V, pa0, pa1, pa2, pa3);
  if (hi == 0) li_l[r32] = l_reg; asm volatile("s_waitcnt lgkmcnt(0)" ::: "memory");
  float rli[16];
#pragma unroll
  for (int r = 0; r < 16; ++r) rli[r] = __builtin_amdgcn_rcpf(li_l[crow(r, hi)]);
  bf16_t* Ow = Ob + (long)(wid * QBLK) * LDO;
#pragma unroll
  for (int r = 0; r < 16; ++r) { int orow = crow(r, hi);
    for (int d0 = 0; d0 < 4; ++d0) Ow[(long)orow * LDO + d0 * 32 + r32] = (bf16_t)f2bf(o[d0][r] * rli[r]); }
  __syncthreads();
#undef SLOAD
#undef SWRITE
#undef SWAIT
#undef RESC
}
#undef SBAR
}

__device__ __forceinline__ void attn_phase(Frame& F) {
    const bf16_t* Q = (const bf16_t*)(F.ws + WS_Q); const bf16_t* KB = (const bf16_t*)(F.ws + WS_KB); const bf16_t* VB = (const bf16_t*)(F.ws + WS_VB); bf16_t* O = (bf16_t*)(F.ws + WS_O);
    for (int i = 0; i < 2; ++i) {
        const int L = i * F.G + F.vcu; if (L >= 512) break;
        const int xcd = (L % F.G) / 32, c = (L % F.G) % 32, grp = xcd >> 1, b = grp >> 1, kv = grp & 1, h = kv * 4 + (xcd & 1) * 2 + (L / F.G), qb = c;
        attn::attn_dense_body(Q + ((size_t)b * SEQ + qb * 256) * 1024 + h * 128, KB + (size_t)b * SKV * 256 + kv * 128, VB + (size_t)b * SKV * 256 + kv * 128,
                              O + ((size_t)b * SEQ + qb * 256) * 1024 + h * 128, SKV, (char*)F.lds);
    }
}

__device__ __forceinline__ void moe_gather_phase(Frame& F) {
    LAS int* ps = (LAS int*)F.lds;
    if (F.tid == 0) { int acc = 0;
        for (int e = 0; e < 8; ++e) { const int c = (int)__hip_atomic_load((unsigned*)(F.ws + WS_CTL) + CW_GCNT + e, RLX_AGENT); const int t = (c + 255) >> 8; ps[e] = acc * 256; ps[8 + e] = c; ps[16 + e] = t;
            if (F.vcu == 0) for (int q = 0; q < t; ++q) ((int*)(F.ws + WS_TILEE))[acc + q] = e;
            acc += t; }
        if (F.vcu == 0) ((int*)(F.ws + WS_TILEE))[200] = acc; }
    __syncthreads();
    const bf16_t* H2 = (const bf16_t*)(F.ws + WS_H2); bf16_t* XGt = (bf16_t*)(F.ws + WS_XGATH);
    const int* TE = (const int*)(F.ws + WS_TOKE); const int* RK = (const int*)(F.ws + WS_RANK); int* DS = (int*)(F.ws + WS_DEST);
    for (int s = F.vcu * NWAVES + F.wave; s < 2 * TL; s += F.G * NWAVES) {
        const int tok = s >> 1, k = s & 1; const int e = (TE[tok] >> (8 * k)) & 0xff; const int dest = ps[e] + RK[s];
        if (F.lane == 0) DS[s] = dest;
        const u32x4* src = (const u32x4*)(H2 + (size_t)tok * 1024); u32x4* dst = (u32x4*)(XGt + (size_t)dest * 1024);
        dst[F.lane] = src[F.lane]; dst[64 + F.lane] = src[64 + F.lane];
    }
    for (int p = F.vcu * NWAVES + F.wave; p < 8 * 256; p += F.G * NWAVES) {
        const int e = p >> 8, j = p & 255; if (ps[8 + e] + j < ps[16 + e] * 256) { u32x4* dst = (u32x4*)(XGt + (size_t)(ps[e] + ps[8 + e] + j) * 1024); const u32x4 z = {0u, 0u, 0u, 0u}; dst[F.lane] = z; dst[64 + F.lane] = z; }
    }
}
__device__ __forceinline__ void combine_phase(Frame& F) {
    const bf16_t* Y = (const bf16_t*)(F.ws + WS_Y); const int* DS = (const int*)(F.ws + WS_DEST); const float* TW = (const float*)(F.ws + WS_TOKW);
    const float* modl = (const float*)(F.ws + WS_MOD) + 3 * 6144; const float* fg = F.in[28];
    for (int row = F.vcu * NWAVES + F.wave; row < TL; row += F.G * NWAVES) {
        const float* g2 = modl + (row >> 13) * 6144 + 5 * 1024; const int d0 = DS[row * 2], d1 = DS[row * 2 + 1]; const float w0 = TW[row * 2], w1 = TW[row * 2 + 1];
        float* xr = F.out + (size_t)row * 1024; f32x4 v[4]; float ss = 0.f;
#pragma unroll
        for (int j = 0; j < 4; ++j) { const int c = 4 * F.lane + 256 * j; const u32x2 ya = *(const u32x2*)(Y + (size_t)d0 * 1024 + c), yb = *(const u32x2*)(Y + (size_t)d1 * 1024 + c);
            const f32x4 fa = {bflo(ya.x), bfhi(ya.x), bflo(ya.y), bfhi(ya.y)}, fb = {bflo(yb.x), bfhi(yb.x), bflo(yb.y), bfhi(yb.y)};
            v[j] = *(const f32x4*)(xr + c) + *(const f32x4*)(g2 + c) * (fa * w0 + fb * w1);
            ss += (v[j][0] * v[j][0] + v[j][1] * v[j][1]) + (v[j][2] * v[j][2] + v[j][3] * v[j][3]); }
        const float rstd = 1.0f / sqrtf(wave_sum(ss) * (1.0f / 1024.0f) + EPS);
#pragma unroll
        for (int j = 0; j < 4; ++j) { const int c = 4 * F.lane + 256 * j; *(f32x4*)(xr + c) = v[j] * rstd * *(const f32x4*)(fg + c); }
    }
}

constexpr int N_PHASES = 22;
struct Args { const float* in[29]; float* out; unsigned char* ws; int ph_lo, ph_hi, li, pad; };

__global__ void __launch_bounds__(NTHR, 2) fwd_kernel(Args args) {
    extern __shared__ __attribute__((aligned(16))) unsigned char lds[];
    Frame F;
    F.lds = lds; F.tid = threadIdx.x; F.lane = F.tid & 63; F.wave = __builtin_amdgcn_readfirstlane(F.tid >> 6);
    F.G = gridDim.x; { const int bx = blockIdx.x; F.vcu = (F.G % 8 == 0) ? (bx % 8) * (F.G / 8) + bx / 8 : bx; }
#pragma unroll
    for (int i = 0; i < 29; ++i) F.in[i] = args.in[i];
    F.out = args.out; F.ws = args.ws;
    unsigned char* ws = args.ws;
    const float* MOD = (const float*)(ws + WS_MOD);
    for (int u = F.tid; u < (LDS_BYTES - LDSCTL_OFF) / 4; u += NTHR) ((LAS unsigned*)(lds + LDSCTL_OFF))[u] = 0u;
    __syncthreads();
    XcdBarrier bar; bar.bar = (unsigned*)(ws + WS_CTL) + CW_BAR; bar.x = 0; bar.st = nullptr;
    if (MK_SINGLE) bar = xcd_barrier_post((unsigned*)(ws + WS_CTL) + CW_BAR, (volatile LAS unsigned*)(lds + MISC_OFF) + 8);
    const int lo = args.ph_lo, hi = args.ph_hi;
#define IN(k) (lo <= (k) && (k) < hi)
#define SEAM(k) do { if (IN((k) + 1)) { if (MK_SINGLE) xcd_barrier(bar); } } while (0)

    if (IN(0)) { p0_prologue(F); SEAM(0); }
#define PG8_RUN(EPI_T, SCHED_T, g, S, E) pg8::gemm_phase<EPI_T, SCHED_T, true, true>((PG8_LAS unsigned char*)lds, g, S, E)
    if (IN(1)) { modnorm_phase<false>(F, F.in[0], F.in[2], TA, F.in[6], MOD, 0, 1, (bf16_t*)(ws + WS_H)); SEAM(1); }
    if (IN(2)) { const EpiStoreBf16<true> E{(bf16_t*)(ws + WS_XG), 2048, 1 << 20};
        const pg8::Gemm g{(const bf16_t*)(ws + WS_H), (const bf16_t*)(ws + WS_W_IN), TA, 2048, 1024}; pg8::StaticOrder S; S.init(TA, 2048, F.G, (int)blockIdx.x);
        PG8_RUN(EpiStoreBf16<true>, pg8::StaticOrder, g, S, E); SEAM(2); }
    if (IN(3)) { conv_phase(F); SEAM(3); }
    if (IN(4)) {
        for (int L = F.vcu; L < 66 * 8 * 2; L += F.G) { const int pm = L % 66, blk = (L / 66) % 8, d = L / (66 * 8); const Unit u{pm, d};
            const EpiGates E{(const bf16_t*)(ws + WS_XC), (bf16_t*)(ws + WS_LA), (bf16_t*)(ws + WS_BB), F.in[12], F.in[14], (const float*)(ws + WS_C8), blk};
            sgemm_unit(lds, (const bf16_t*)(ws + WS_XC) + (size_t)pm * 256 * 1024 + blk * 128, 1024, (const bf16_t*)(ws + WS_W_GATE) + (size_t)(blk * 512 + d * 256) * 128, 128, 128, E, u); }
        SEAM(4); }
    if (IN(5)) { scan_agg_phase(F); SEAM(5); }
    if (IN(6)) { scan_carry_phase(F); SEAM(6); }
    if (IN(7)) { scan_apply_phase(F); SEAM(7); }
    if (IN(8)) { const EpiResid E{F.in[0], F.out, F.in[2], (float*)(ws + WS_CTXR), MOD, 2048};
        const pg8::Gemm g{(const bf16_t*)(ws + WS_YG), (const bf16_t*)(ws + WS_W_OUT), TA, 1024, 1024}; pg8::StaticOrder S; S.init(TA, 1024, F.G, (int)blockIdx.x);
        PG8_RUN(EpiResid, pg8::StaticOrder, g, S, E); SEAM(8); }
    if (IN(9)) { modnorm_phase<false>(F, F.out, (const float*)(ws + WS_CTXR), TA, F.in[7], MOD, 3, 4, (bf16_t*)(ws + WS_H)); SEAM(9); }
    if (IN(10)) { const EpiSwiglu<true> E{(bf16_t*)(ws + WS_HID), DFF, 1 << 20};
        const pg8::Gemm g{(const bf16_t*)(ws + WS_H), (const bf16_t*)(ws + WS_W13), TA, 2 * DFF, 1024}; pg8::StaticOrder S; S.init(TA, 2 * DFF, F.G, (int)blockIdx.x);
        PG8_RUN(EpiSwiglu<true>, pg8::StaticOrder, g, S, E); SEAM(10); }
    if (IN(11)) { const EpiResid E{F.out, F.out, (const float*)(ws + WS_CTXR), (float*)(ws + WS_CTXR), MOD, 5120};
        const pg8::Gemm g{(const bf16_t*)(ws + WS_HID), (const bf16_t*)(ws + WS_W2), TA, 1024, DFF}; pg8::StaticOrder S; S.init(TA, 1024, F.G, (int)blockIdx.x);
        PG8_RUN(EpiResid, pg8::StaticOrder, g, S, E); SEAM(11); }
    if (IN(12)) { modnorm_phase<false>(F, F.out, (const float*)(ws + WS_CTXR), TA, F.in[6] + 1024, MOD + 3 * 6144, 0, 1, (bf16_t*)(ws + WS_H)); SEAM(12); }
    if (IN(13)) { const EpiQKV<true> E{(bf16_t*)(ws + WS_Q), (bf16_t*)(ws + WS_KB), (bf16_t*)(ws + WS_VB)};
        const pg8::Gemm g{(const bf16_t*)(ws + WS_H), (const bf16_t*)(ws + WS_W_QKV), TA, NQKV, 1024}; pg8::StaticOrder S; S.init(TA, NQKV, F.G, (int)blockIdx.x);
        PG8_RUN(EpiQKV<true>, pg8::StaticOrder, g, S, E); SEAM(13); }
    if (IN(14)) { qkrope_phase(F); SEAM(14); }
    if (IN(15)) { attn_phase(F); SEAM(15); }
    if (IN(16)) { const EpiResid E{F.out, F.out, nullptr, nullptr, MOD + 3 * 6144, 2048};
        const pg8::Gemm g{(const bf16_t*)(ws + WS_O), (const bf16_t*)(ws + WS_W_O), TL, 1024, 1024}; pg8::StaticOrder S; S.init(TL, 1024, F.G, (int)blockIdx.x);
        PG8_RUN(EpiResid, pg8::StaticOrder, g, S, E); SEAM(16); }
    if (IN(17)) { modnorm_phase<true>(F, F.out, nullptr, TL, F.in[7] + 1024, MOD + 3 * 6144, 3, 4, (bf16_t*)(ws + WS_H2)); SEAM(17); }
    if (IN(18)) { moe_gather_phase(F); SEAM(18); }
    if (IN(19)) { const int* TLE = (const int*)(ws + WS_TILEE); const int nMt = __builtin_amdgcn_readfirstlane(TLE[200]); const EpiSwiglu<true> E{(bf16_t*)(ws + WS_MHID), DFE, 28};
        const pg8::Gemm g{(const bf16_t*)(ws + WS_XGATH), (const bf16_t*)(ws + WS_MW13), nMt * 256, 2 * DFE, 1024}; MoeOrder S; S.init(nMt, 28, F.G, (int)blockIdx.x, TLE);
        PG8_RUN(EpiSwiglu<true>, MoeOrder, g, S, E); SEAM(19); }
    if (IN(20)) { const int* TLE = (const int*)(ws + WS_TILEE); const int nMt = __builtin_amdgcn_readfirstlane(TLE[200]); const EpiStoreBf16<true> E{(bf16_t*)(ws + WS_Y), 1024, 4};
        const pg8::Gemm g{(const bf16_t*)(ws + WS_MHID), (const bf16_t*)(ws + WS_MW2), nMt * 256, 1024, DFE}; MoeOrder S; S.init(nMt, 4, F.G, (int)blockIdx.x, TLE);
        PG8_RUN(EpiStoreBf16<true>, MoeOrder, g, S, E); SEAM(20); }
    if (IN(21)) { combine_phase(F); }
#undef PG8_RUN
#undef IN
#undef SEAM
}

extern "C" void kernel_launch(void* const* d_in, const int* in_sizes, int n_in, void* d_out, int out_size, void* d_ws, size_t ws_size, hipStream_t stream) {
    static int grid = 0;
    if (grid == 0) {
        if (n_in != 29 || out_size != TL * D || ws_size < WS_END) { fprintf(stderr, "kernel_launch: unexpected shapes: n_in %d out %d ws %zu (need %zu)\n", n_in, out_size, ws_size, (size_t)WS_END); grid = -1; return; }
        int dev = 0, cus = 0;
        if (hipGetDevice(&dev) != hipSuccess || hipDeviceGetAttribute(&cus, hipDeviceAttributeMultiprocessorCount, dev) != hipSuccess) { grid = -1; return; }
        if (hipFuncSetAttribute((const void*)fwd_kernel, hipFuncAttributeMaxDynamicSharedMemorySize, LDS_BYTES) != hipSuccess) { fprintf(stderr, "kernel_launch: hipFuncSetAttribute failed\n"); grid = -1; return; }
        int per_cu = 0; (void)hipOccupancyMaxActiveBlocksPerMultiprocessor(&per_cu, (const void*)fwd_kernel, NTHR, LDS_BYTES); (void)hipGetLastError();
        grid = cus;
    }
    if (grid < 0) return;
    (void)hipMemsetAsync((char*)d_ws + WS_CTL, 0, CTL_ZERO_BYTES, stream);
    Args a{};
    for (int i = 0; i < 29; ++i) a.in[i] = (const float*)d_in[i];
    a.out = (float*)d_out; a.ws = (unsigned char*)d_ws;
#if MK_SINGLE
    a.ph_lo = 0; a.ph_hi = N_PHASES; a.li = 0;
    hipLaunchKernelGGL(fwd_kernel, dim3(grid), dim3(NTHR), LDS_BYTES, stream, a);
#else
    for (int p = 0; p < N_PHASES; ++p) { a.ph_lo = p; a.ph_hi = p + 1; a.li = p; hipLaunchKernelGGL(fwd_kernel, dim3(grid), dim3(NTHR), LDS_BYTES, stream, a); }
#endif
    const hipError_t le = hipPeekAtLastError();
    if (le != hipSuccess) fprintf(stderr, "kernel_launch: launch failed: %s\n", hipGetErrorName(le));
}
```
